# Optimizing an MI355X kernel written in HIP

```python
import jax, jax.numpy as jnp
from jax import lax
import numpy as np

D_MODEL = 1024
BATCH = 4
SEQ = 8192
DEPTH = 4

ATTN_HEADS = 8
ATTN_KV_HEADS = 2
ATTN_HEAD_DIM = 64
ATTN_GROUP = ATTN_HEADS // ATTN_KV_HEADS
ATTN_WIDTH = ATTN_HEADS * ATTN_HEAD_DIM
KV_WIDTH = ATTN_KV_HEADS * ATTN_HEAD_DIM
WINDOW = 128
ATTN_BLOCK = WINDOW
ROPE_THETA = 500000.0
ROPE_DIM = ATTN_HEAD_DIM // 4
REC_HEADS = 4
REC_KEY_DIM = 128
REC_VAL_DIM = 128
REC_KEY_WIDTH = REC_HEADS * REC_KEY_DIM
REC_WIDTH = REC_HEADS * REC_VAL_DIM
REC_CHUNK = 64
MIX_WIDTH = ATTN_WIDTH + REC_WIDTH
SPLIT_SIZES = (ATTN_WIDTH, KV_WIDTH, KV_WIDTH, REC_KEY_WIDTH, REC_KEY_WIDTH, REC_WIDTH, REC_WIDTH)
IN_WIDTH = 2816
N_GROUPS = 4
EXPERTS_PER_GROUP = 8
N_EXPERTS = N_GROUPS * EXPERTS_PER_GROUP
TOP_K = 2
EXPERT_FF = 512
MOE_BLOCK = 128
PLE_DIM = 256
RMS_EPS = 1e-6
MASK_VALUE = -1e30

kernel_name = 'hymba_swa_hgrn2_hiermoe_ple'

F32 = jnp.float32


def rms_norm(x, gain):
    xf = x.astype(F32)
    y = xf * lax.rsqrt(jnp.mean(xf * xf, axis=-1, keepdims=True) + RMS_EPS)
    return (y * gain.astype(F32)).astype(x.dtype)


def apply_partial_rope(x, cos, sin):
    half = ROPE_DIM // 2
    xf = x.astype(F32)
    x1 = xf[..., :half]
    x2 = xf[..., half:ROPE_DIM]
    out = jnp.concatenate([x1 * cos - x2 * sin, x2 * cos + x1 * sin, xf[..., ROPE_DIM:]], axis=-1)
    return out.astype(x.dtype)


def sliding_window_attention(q, k, v, sinks):
    B, S = q.shape[0], q.shape[1]
    nb = S // ATTN_BLOCK
    qb = q.reshape(B, nb, ATTN_BLOCK, ATTN_KV_HEADS, ATTN_GROUP, ATTN_HEAD_DIM)

    def with_prev_block(t):
        tb = t.reshape(B, nb, ATTN_BLOCK, ATTN_KV_HEADS, ATTN_HEAD_DIM)
        prev = jnp.pad(tb[:, :-1], ((0, 0), (1, 0), (0, 0), (0, 0), (0, 0)))
        return jnp.concatenate([prev, tb], axis=2)

    kc = with_prev_block(k)
    vc = with_prev_block(v)
    scores = jnp.einsum('bnqhgd,bnkhd->bnhgqk', qb, kc).astype(F32) * (ATTN_HEAD_DIM ** -0.5)
    qi = jnp.arange(ATTN_BLOCK)[:, None]
    kj = jnp.arange(2 * ATTN_BLOCK)[None, :]
    dist = ATTN_BLOCK + qi - kj
    in_window = (dist >= 0) & (dist < WINDOW)
    key_exists = (jnp.arange(nb) > 0)[:, None, None] | (kj >= ATTN_BLOCK)[None]
    mask = (in_window[None] & key_exists)[None, :, None, None]
    scores = jnp.where(mask, scores, MASK_VALUE)
    sink = sinks.astype(F32).reshape(1, 1, ATTN_KV_HEADS, ATTN_GROUP, 1, 1)
    m = jnp.maximum(jnp.max(scores, axis=-1, keepdims=True), sink)
    e = jnp.exp(scores - m)
    denom = jnp.sum(e, axis=-1, keepdims=True) + jnp.exp(sink - m)
    probs = (e / denom).astype(v.dtype)
    out = jnp.einsum('bnhgqk,bnkhd->bnqhgd', probs, vc)
    return out.reshape(B, S, ATTN_WIDTH)


def hgrn2(q, f, i, og, lb, out_gain):
    B, S = q.shape[0], q.shape[1]
    nc = S // REC_CHUNK
    fz = f.astype(F32)
    lbf = lb.astype(F32)
    forget = lbf + (1.0 - lbf) * jax.nn.sigmoid(fz)
    log_f = jnp.log(forget)
    key = (1.0 - lbf) * jax.nn.sigmoid(-fz)
    qf = jax.nn.silu(q.astype(F32))
    vf = i.astype(F32)

    def chunked(t, d):
        return t.reshape(B, nc, REC_CHUNK, REC_HEADS, d).transpose(1, 0, 3, 2, 4)

    qc = chunked(qf, REC_KEY_DIM)
    kc = chunked(key, REC_KEY_DIM)
    vc = chunked(vf, REC_VAL_DIM)
    bc = jnp.cumsum(chunked(log_f, REC_KEY_DIM), axis=3)
    causal = jnp.tril(jnp.ones((REC_CHUNK, REC_CHUNK), dtype=bool))[:, :, None]

    def step(state, xs):
        qt, kt, vt, bt = xs
        rel = jnp.where(causal, bt[:, :, :, None, :] - bt[:, :, None, :, :], MASK_VALUE)
        a = jnp.einsum('bhtd,bhsd,bhtsd->bhts', qt, kt, jnp.exp(rel))
        o = (jnp.einsum('bhts,bhse->bhte', a, vt)
             + jnp.einsum('bhtd,bhde->bhte', qt * jnp.exp(bt), state))
        b_last = bt[:, :, -1, :]
        state = (state * jnp.exp(b_last)[..., None]
                 + jnp.einsum('bhsd,bhse->bhde', kt * jnp.exp(b_last[:, :, None, :] - bt), vt))
        return state, o

    s0 = jnp.zeros((B, REC_HEADS, REC_KEY_DIM, REC_VAL_DIM), F32)
    _, o = lax.scan(step, s0, (qc, kc, vc, bc))
    o = o.transpose(1, 0, 3, 2, 4).reshape(B, S, REC_HEADS, REC_VAL_DIM)
    o = rms_norm(o, out_gain).reshape(B, S, REC_WIDTH)
    return (o * jax.nn.silu(og.astype(F32))).astype(og.dtype)


def hierarchical_moe(xn, w_router_group, w_router_expert, w_gate, w_up, w_down):
    B, S, D = xn.shape
    T = B * S
    A = T * TOP_K
    xt = xn.reshape(T, D)
    g_logits = (xt @ w_router_group).astype(F32)
    g_prob = jax.nn.softmax(g_logits, axis=-1)
    g_val, g_idx = lax.top_k(g_logits, 1)
    p_group = jnp.take_along_axis(g_prob, g_idx, axis=-1)
    e_logits = (xt @ w_router_expert).astype(F32).reshape(T, N_GROUPS, EXPERTS_PER_GROUP)
    e_logits = jnp.take_along_axis(e_logits, g_idx[:, :, None], axis=1)[:, 0]
    top_val, top_idx = lax.top_k(e_logits, TOP_K)
    weights = p_group * jax.nn.softmax(top_val, axis=-1)
    expert = g_idx * EXPERTS_PER_GROUP + top_idx

    e_flat = expert.reshape(A)
    w_flat = weights.reshape(A)
    tok_flat = jnp.arange(A, dtype=jnp.int32) // TOP_K
    order = jnp.argsort(e_flat)
    e_sorted = e_flat[order]
    tok_sorted = tok_flat[order]
    w_sorted = w_flat[order]
    counts = jnp.bincount(e_flat, length=N_EXPERTS)
    start = jnp.cumsum(counts) - counts
    padded = ((counts + MOE_BLOCK - 1) // MOE_BLOCK) * MOE_BLOCK
    pad_end = jnp.cumsum(padded)
    pad_start = pad_end - padded
    rank = jnp.arange(A, dtype=jnp.int32) - start[e_sorted]
    dest = pad_start[e_sorted] + rank
    n_rows = A + N_EXPERTS * MOE_BLOCK
    n_blocks = n_rows // MOE_BLOCK
    rows = jnp.zeros((n_rows, D), xt.dtype).at[dest].set(xt[tok_sorted])
    block_start = jnp.arange(n_blocks, dtype=jnp.int32) * MOE_BLOCK
    block_expert = jnp.clip(jnp.searchsorted(pad_end, block_start, side='right'), 0, N_EXPERTS - 1)

    def expert_block(args):
        xb, e = args
        hidden = jax.nn.silu(xb @ w_gate[e]) * (xb @ w_up[e])
        return hidden @ w_down[e]

    y_rows = lax.map(expert_block, (rows.reshape(n_blocks, MOE_BLOCK, D), block_expert))
    y_rows = y_rows.reshape(n_rows, D)
    contrib = y_rows[dest] * w_sorted[:, None].astype(y_rows.dtype)
    y = jax.ops.segment_sum(contrib, tok_sorted, num_segments=T)
    return y.reshape(B, S, D).astype(xn.dtype)


def setup_inputs(seed: int = 0) -> dict:
    key = jax.random.key(seed)
    ks = jax.random.split(key, 24)

    def nrm(k, shape, scale):
        return jax.random.normal(k, shape, F32) * scale

    def gain(k, shape):
        return 1.0 + 0.01 * jax.random.normal(k, shape, F32)

    x = nrm(ks[0], (BATCH, SEQ, D_MODEL), 1.0)
    p = nrm(ks[1], (DEPTH, BATCH, SEQ, PLE_DIM), 1.0)
    positions = (jnp.arange(SEQ, dtype=jnp.int32)[None, :]
                 + jax.random.randint(ks[2], (BATCH, 1), 0, 1024, dtype=jnp.int32))
    return {
        'x': x,
        'p': p,
        'positions': positions,
        'mix_norm': gain(ks[3], (DEPTH, D_MODEL)),
        'w_in': nrm(ks[4], (DEPTH, D_MODEL, IN_WIDTH), D_MODEL ** -0.5),
        'q_norm': gain(ks[5], (DEPTH, ATTN_HEAD_DIM)),
        'k_norm': gain(ks[6], (DEPTH, ATTN_HEAD_DIM)),
        'sinks': nrm(ks[7], (DEPTH, ATTN_HEADS), 0.5),
        'lb_logits': nrm(ks[8], (DEPTH, REC_KEY_WIDTH), 0.1),
        'rec_norm': gain(ks[9], (DEPTH, REC_VAL_DIM)),
        'w_out': nrm(ks[10], (DEPTH, MIX_WIDTH, D_MODEL), MIX_WIDTH ** -0.5),
        'ffn_norm': gain(ks[11], (DEPTH, D_MODEL)),
        'w_router_group': nrm(ks[12], (DEPTH, D_MODEL, N_GROUPS), D_MODEL ** -0.5),
        'w_router_expert': nrm(ks[13], (DEPTH, D_MODEL, N_EXPERTS), D_MODEL ** -0.5),
        'w_gate': nrm(ks[14], (DEPTH, N_EXPERTS, D_MODEL, EXPERT_FF), D_MODEL ** -0.5),
        'w_up': nrm(ks[15], (DEPTH, N_EXPERTS, D_MODEL, EXPERT_FF), D_MODEL ** -0.5),
        'w_down': nrm(ks[16], (DEPTH, N_EXPERTS, EXPERT_FF, D_MODEL), EXPERT_FF ** -0.5),
        'w_ple': nrm(ks[17], (DEPTH, PLE_DIM, D_MODEL), PLE_DIM ** -0.5),
        'ple_norm': gain(ks[18], (DEPTH, D_MODEL)),
        'ple_gate_norm': gain(ks[19], (DEPTH, D_MODEL)),
        'w_ple_gate': nrm(ks[20], (DEPTH, D_MODEL, D_MODEL), D_MODEL ** -0.5),
    }


def reference(x, p, positions, mix_norm, w_in, q_norm, k_norm, sinks, lb_logits, rec_norm,
              w_out, ffn_norm, w_router_group, w_router_expert, w_gate, w_up, w_down,
              w_ple, ple_norm, ple_gate_norm, w_ple_gate):
    B, S, _ = x.shape
    inv_freq = ROPE_THETA ** (-jnp.arange(0, ROPE_DIM, 2, dtype=F32) / ROPE_DIM)
    ang = positions.astype(F32)[..., None] * inv_freq
    cos = jnp.cos(ang)[:, :, None, :]
    sin = jnp.sin(ang)[:, :, None, :]
    lb_sm = jax.nn.softmax(lb_logits.astype(F32), axis=0)
    lower_bounds = jnp.cumsum(lb_sm, axis=0) - lb_sm[0:1]
    split_points = []
    acc = 0
    for sz in SPLIT_SIZES[:-1]:
        acc += sz
        split_points.append(acc)

    h = x
    for l in range(DEPTH):
        xn = rms_norm(h, mix_norm[l])
        z = xn @ w_in[l]
        qa, ka, va, qr, fr, ir, gr = jnp.split(z, split_points, axis=-1)
        qa = apply_partial_rope(rms_norm(qa.reshape(B, S, ATTN_HEADS, ATTN_HEAD_DIM), q_norm[l]), cos, sin)
        ka = apply_partial_rope(rms_norm(ka.reshape(B, S, ATTN_KV_HEADS, ATTN_HEAD_DIM), k_norm[l]), cos, sin)
        va = va.reshape(B, S, ATTN_KV_HEADS, ATTN_HEAD_DIM)
        attn = sliding_window_attention(qa, ka, va, sinks[l])
        rec = hgrn2(qr, fr, ir, gr, lower_bounds[l], rec_norm[l])
        mixed = jnp.concatenate([attn.astype(h.dtype), rec.astype(h.dtype)], axis=-1)
        h = h + (mixed @ w_out[l]).astype(h.dtype)
        h = h + hierarchical_moe(rms_norm(h, ffn_norm[l]), w_router_group[l], w_router_expert[l],
                                 w_gate[l], w_up[l], w_down[l]).astype(h.dtype)
        ple = rms_norm(p[l] @ w_ple[l], ple_norm[l]).astype(F32)
        gate = jax.nn.sigmoid((rms_norm(h, ple_gate_norm[l]) @ w_ple_gate[l]).astype(F32))
        h = h + (ple * gate).astype(h.dtype)
    return h
```

```cpp
#include <hip/hip_runtime.h>
#include <cstdio>
#include <cstdint>

#ifndef ONE_LAUNCH
#define ONE_LAUNCH 1
#endif
#ifndef PH_HI
#define PH_HI 41

#endif

#define LAS __attribute__((address_space(3)))
typedef unsigned short bf16;
typedef short bf16x8 __attribute__((ext_vector_type(8)));
typedef short s16x4 __attribute__((ext_vector_type(4)));
typedef float f32x4 __attribute__((ext_vector_type(4)));
typedef float f32x16 __attribute__((ext_vector_type(16)));
typedef unsigned u32x4 __attribute__((ext_vector_type(4)));
typedef unsigned u32x2 __attribute__((ext_vector_type(2)));
typedef int v8i __attribute__((ext_vector_type(8)));
typedef short s16x16 __attribute__((ext_vector_type(16)));

constexpr int D = 1024, BATCH = 4, SEQ = 8192, DEPTH = 4, M = BATCH * SEQ;
constexpr int IN_W = 2816;
constexpr int NEXP = 32, FF = 512, PLE = 256;
constexpr int NGRP = 64;
constexpr float EPS = 1e-6f;

constexpr size_t MiB = 1u << 20;
constexpr size_t WS_CTL = 0, CTL_ZERO_BYTES = 1 * MiB;
constexpr float HID_SCALE = 4.f, WD_SCALE = 32.f;
constexpr float MIX_SCALE = 4.f, WOUT_SCALE = 32.f;
constexpr size_t WS_WIN = 1 * MiB, WS_WOUT = 23 * MiB, WS_WPLE = 31 * MiB, WS_WPG = 33 * MiB, WS_WR = 41 * MiB, WS_MISC = 42 * MiB;
constexpr size_t WS_WGU = 48 * MiB, WS_WD = 304 * MiB, WS_HB = 432 * MiB, WS_Q = 496 * MiB, WS_K = 528 * MiB, WS_V = 536 * MiB;
constexpr size_t WS_QR = 544 * MiB, WS_KEY = 576 * MiB, WS_IR = 608 * MiB, WS_GR = 640 * MiB, WS_LF = 672 * MiB, WS_MIX = 736 * MiB;
constexpr size_t WS_USUP = 800 * MiB, WS_PB = 832 * MiB, WS_TOKL = 896 * MiB, WS_WL = 904 * MiB, WS_HB2 = 912 * MiB, WS_SS = 976 * MiB, WS_CHS = 984 * MiB, WS_END = 988 * MiB;
constexpr size_t WS_HB2F8 = 176 * MiB;
constexpr size_t WS_HID = WS_QR;
constexpr size_t WS_PLERAW = WS_LF;
constexpr size_t SS_MIX = WS_SS, SS_FFN = WS_SS + 2 * MiB, SS_PG = WS_SS + 4 * MiB, SS_PLE = WS_SS + 6 * MiB;
constexpr size_t MISC_COS = 1 * MiB, MISC_SIN = 2 * MiB, MISC_LB = 3 * MiB, MISC_DSUP = 4 * MiB;
constexpr int CW_TMO = 0, CW_CNT = 1024, CW_BAR = 4096;

constexpr int STAGE_BYTES = 131072;
constexpr int LC_BASE = 133120;
constexpr int LC_PRE = LC_BASE, LC_CNT = LC_BASE + 320, LC_BAR = LC_BASE + 576;
constexpr int LDS_BYTES = LC_BASE + 2048;

__device__ __forceinline__ unsigned f2bf(float f) { unsigned u = __builtin_bit_cast(unsigned, f); return (u + 0x7fffu + ((u >> 16) & 1u)) >> 16; }
__device__ __forceinline__ unsigned pk2(float lo, float hi) { return f2bf(lo) | (f2bf(hi) << 16); }
__device__ __forceinline__ float bf2f(unsigned b) { return __builtin_bit_cast(float, b << 16); }
__device__ __forceinline__ unsigned cvt_pk_bf16(float lo, float hi) { unsigned r; asm volatile("v_cvt_pk_bf16_f32 %0, %1, %2" : "=v"(r) : "v"(lo), "v"(hi)); return r; }
__device__ __forceinline__ float fast_exp(float x) { return __builtin_amdgcn_exp2f(x * 1.4426950408889634f); }
__device__ __forceinline__ float silu(float x) { const float t = fast_exp(-x); return x * __builtin_amdgcn_rcpf(1.f + t); }
__device__ __forceinline__ float clamp_f8(float x) { float y; asm("v_max_f32 %0, 0xc3e00000, %1\n\tv_min_f32 %0, 0x43e00000, %0" : "=&v"(y) : "v"(x)); return y; }
__device__ __forceinline__ u32x2 pk_fp8x8(const f32x4& a, const f32x4& b) {
    int lo = __builtin_amdgcn_cvt_pk_fp8_f32(a[0], a[1], 0, false); lo = __builtin_amdgcn_cvt_pk_fp8_f32(a[2], a[3], lo, true);
    int hi = __builtin_amdgcn_cvt_pk_fp8_f32(b[0], b[1], 0, false); hi = __builtin_amdgcn_cvt_pk_fp8_f32(b[2], b[3], hi, true);
    u32x2 r; r.x = (unsigned)lo; r.y = (unsigned)hi; return r;
}
typedef _Float16 h16x2 __attribute__((ext_vector_type(2)));
#define MFMA16(a, b, c) __builtin_amdgcn_mfma_f32_16x16x32_bf16((a), (b), (c), 0, 0, 0)
#define MFMA32(a, b, c) __builtin_amdgcn_mfma_f32_32x32x16_bf16((a), (b), (c), 0, 0, 0)

#define GAS1 __attribute__((address_space(1)))
template <class T> __device__ __forceinline__ T* GP(T* p) { GAS1 T* g = (GAS1 T*)p; asm volatile("" : "+s"(g)); return (T*)g; }
__device__ __forceinline__ int lane_here() { int l; asm volatile("v_mbcnt_lo_u32_b32 %0, -1, 0\n\tv_mbcnt_hi_u32_b32 %0, -1, %0" : "=v"(l)); return l; }
__device__ __forceinline__ float shx(float v, int m) { return __builtin_bit_cast(float, __builtin_amdgcn_ds_bpermute((lane_here() ^ m) << 2, __builtin_bit_cast(int, v))); }
__device__ __forceinline__ float shl15(float v) { return __builtin_bit_cast(float, __builtin_amdgcn_ds_bpermute((lane_here() | 15) << 2, __builtin_bit_cast(int, v))); }
__device__ __forceinline__ const float* inp(int k) {
    unsigned long long kp = (unsigned long long)__builtin_amdgcn_kernarg_segment_ptr(); asm volatile("" : "+s"(kp));
    return (const float*)(GAS1 const float*)((const unsigned long long __attribute__((address_space(4)))*)kp)[k];
}

__device__ __forceinline__ int opaque_tid(int wave) {
    return wave * 64 + lane_here(); }

#define XB_TMO      128
#define XB_XCNT(j)  (256  + 64 * (j))
#define XB_XSUB(j)  (1280 + 64 * (j))
#define XB_XGEN(j)  (2304 + 64 * (j))
#define XB_TOP      3328
#define XB_TOPGEN   3392
#define XCD_BAR_WORDS 3456
#define XB_SPIN_CAP (1u << 18)
__device__ __forceinline__ unsigned xb_ld(unsigned* p)              { return __hip_atomic_load(p, __ATOMIC_RELAXED, __HIP_MEMORY_SCOPE_AGENT); }
__device__ __forceinline__ unsigned xb_add(unsigned* p, unsigned v) { return __hip_atomic_fetch_add(p, v, __ATOMIC_RELAXED, __HIP_MEMORY_SCOPE_AGENT); }
__device__ __forceinline__ unsigned xb_xcc_id() { return (unsigned)__builtin_amdgcn_s_getreg((3 << 11) | 20) & 0xFu; }
#define XB_SPIN(cond, bar) do { unsigned _sp = 0; while (cond) { __builtin_amdgcn_s_sleep(1); \
    if ((++_sp & 255u) == 0u) { if (xb_ld(&(bar)[XB_TMO])) break; if (_sp > XB_SPIN_CAP) { atomicAdd(&(bar)[XB_TMO], 1u); break; } } } } while (0)
struct XcdBarrier { unsigned* bar; unsigned x; volatile LAS unsigned* st; };
__device__ __forceinline__ XcdBarrier xcd_barrier_post(unsigned* bar, volatile LAS unsigned* st) {
    XcdBarrier b; b.bar = bar; b.x = xb_xcc_id(); b.st = st;
    if (threadIdx.x == 0) (void)xb_add(&bar[XB_XCNT(b.x)], 1u);
    return b;
}
__device__ __forceinline__ void xcd_barrier_complete(unsigned* bar, unsigned x, unsigned& nloc, unsigned& nx) {
    const unsigned G = gridDim.x * gridDim.y * gridDim.z;
    unsigned sum, cnt, mine, sp = 0u;
    for (;;) {
        sum = 0u; cnt = 0u; mine = 0u;
#pragma unroll
        for (unsigned j = 0; j < 16; ++j) { const unsigned c = xb_ld(&bar[XB_XCNT(j)]); sum += c; cnt += (c > 0u) ? 1u : 0u; mine = (j == x) ? c : mine; }
        if (sum == G) break;
        __builtin_amdgcn_s_sleep(1);
        if ((++sp & 255u) == 0u) { if (xb_ld(&bar[XB_TMO])) break; if (sp > XB_SPIN_CAP) { atomicAdd(&bar[XB_TMO], 1u); break; } }
    }
    nloc = mine > 0u ? mine : 1u; nx = cnt > 0u ? cnt : 1u;
}
__device__ __forceinline__ void xcd_barrier(const XcdBarrier& b, const int wave) {
    asm volatile("s_waitcnt vmcnt(0)" ::: "memory");
    __syncthreads();
    if (wave == 0 && lane_here() == 0) {
        unsigned* bar = GP(b.bar);
        __builtin_amdgcn_s_waitcnt(0);
        unsigned nloc = b.st[0], nx = b.st[1];
        if (nloc == 0u) { xcd_barrier_complete(bar, b.x, nloc, nx); b.st[0] = nloc; b.st[1] = nx; }
        const unsigned old = xb_add(&bar[XB_XSUB(b.x)], 1u);
        const unsigned gen = old / nloc;
        if (old + 1u == (gen + 1u) * nloc) {
            __builtin_amdgcn_fence(__ATOMIC_RELEASE, "agent");
            asm volatile("s_waitcnt vmcnt(0)" ::: "memory");
            const unsigned og = xb_add(&bar[XB_TOP], 1u);
            const unsigned tg = og / nx;
            if (og + 1u == (tg + 1u) * nx) xb_add(&bar[XB_TOPGEN], 1u);
            else XB_SPIN(xb_ld(&bar[XB_TOPGEN]) == tg, bar);
            __builtin_amdgcn_fence(__ATOMIC_ACQUIRE, "agent");
            xb_add(&bar[XB_XGEN(b.x)], 1u);
            asm volatile("s_waitcnt vmcnt(0)" ::: "memory");
        } else {
            XB_SPIN(xb_ld(&bar[XB_XGEN(b.x)]) == gen, bar);
            __builtin_amdgcn_fence(__ATOMIC_ACQUIRE, "agent");
            asm volatile("s_waitcnt vmcnt(0)" ::: "memory");
        }
    }
    __syncthreads();
}

namespace pg8 {
constexpr int BM = 256, BK = 64, HALF = 128, HTB = HALF * BK * 2, NXCD = 8, WGM = 8;
__device__ __forceinline__ int lds_byte(int r, int c) { const int st = (r >> 4) * 2 + (c >> 5), rr = r & 15, cc = c & 31, ob = rr * 64 + cc * 2; return st * 1024 + (ob ^ (((ob >> 9) & 1) << 5)); }
__device__ __forceinline__ void stage_rc(int b, int& R, int& C) { const int st = b / 1024, sb = b % 1024, swz = sb ^ (((sb >> 9) & 1) << 5); R = (st >> 1) * 16 + swz / 64; C = (st & 1) * 32 + (swz % 64) / 2; }
__device__ __forceinline__ int perm32(int rho) { const int n = rho >> 4, i = rho & 15; return 8 * (i >> 2) + 4 * n + (i & 3); }
struct Unit { int pm, pn, g, mt; };

struct StaticOrder {
    int nM, nN, nwg, G, c;
    __device__ void init(int M_, int N_, int G_, int c_) { nM = M_ / BM; nN = N_ / BM; nwg = nM * nN; G = G_; c = c_; }
    __device__ bool next(int i, Unit& u) const { return at((long)i * G + c, u); }
    __device__ bool at(long L, Unit& u) const {
        if (L >= nwg) return false;
        int wgid = (int)L; { const int q = nwg / NXCD, r = nwg % NXCD, xcd = wgid % NXCD, off = wgid / NXCD; wgid = (xcd < r ? xcd * (q + 1) : r * (q + 1) + (xcd - r) * q) + off; }
        const int nig = WGM * nN, gid = wgid / nig, fm = gid * WGM, gsz = (nM - fm) < WGM ? (nM - fm) : WGM;
        u.pm = fm + ((wgid % nig) % gsz); u.pn = (wgid % nig) / gsz; u.g = 0; u.mt = 0; return true;
    }
};
struct RegSched {
    static constexpr bool LANE_PER_UNIT = false;
    StaticOrder so; const char* A; const char* Bt; int K;
    __device__ __forceinline__ bool next(int i, Unit& u) const { return so.next(i, u); }
    __device__ __forceinline__ const char* a_ubase(const Unit& u) const { return A + (size_t)u.pm * BM * K * 2; }
    __device__ __forceinline__ size_t hstepA() const { return (size_t)HALF * K * 2; }
    __device__ __forceinline__ unsigned a_lane(const Unit&, int, int R, unsigned c2) const { return (unsigned)(R * K * 2) + c2; }
    __device__ __forceinline__ const char* b_base(const Unit& u) const { return Bt + (size_t)u.pn * BM * K * 2; }
};
struct InSched {
    static constexpr bool LANE_PER_UNIT = false;
    StaticOrder soA, soB; const char* A; const char* Bt; int K; bool split;
    __device__ __forceinline__ bool next(int i, Unit& u) const {
        bool ok;
        if (split) {
            const int c = soA.c, h = c >> 7, cl = c & 127, nA = h ? 3 : 1;
            if (i < nA) { ok = soA.at(h ? (long)i * 128 + cl : 384 + cl, u); u.pn = 3 + 2 * u.pn; return ok; }
            const int j = i - nA; if (j >= (h ? 2 : 5)) return false;
            ok = soB.at(h ? 640 + (long)j * 128 + cl : (long)j * 128 + cl, u);
        } else {
            if (i < 2) { ok = soA.next(i, u); u.pn = 3 + 2 * u.pn; return ok; }
            ok = soB.next(i - 2, u);
        }
        u.pn = (u.pn < 3) ? u.pn : 2 * u.pn - 2; return ok;
    }
    __device__ __forceinline__ const char* a_ubase(const Unit& u) const { return A + (size_t)u.pm * BM * K * 2; }
    __device__ __forceinline__ size_t hstepA() const { return (size_t)HALF * K * 2; }
    __device__ __forceinline__ unsigned a_lane(const Unit&, int, int R, unsigned c2) const { return (unsigned)(R * K * 2) + c2; }
    __device__ __forceinline__ const char* b_base(const Unit& u) const { return Bt + (size_t)u.pn * BM * K * 2; }
};
struct TailSched {
    static constexpr bool LANE_PER_UNIT = false;
    int nunits, nbig, G, c, ubase; const char* A; const char* Bt; int K;
    __device__ __forceinline__ bool next(int i, Unit& u) const {
        const int nt = G - nbig, ct = c - nbig; if (ct < 0) return false;
        int U = i * nt + ct; if (U >= nunits) return false;
        U += ubase; u.pm = U >> 2; u.pn = U & 3; u.g = 0; u.mt = 0; return true;
    }
    __device__ __forceinline__ const char* a_ubase(const Unit& u) const { return A + (size_t)u.pm * BM * K * 2; }
    __device__ __forceinline__ size_t hstepA() const { return (size_t)HALF * K * 2; }
    __device__ __forceinline__ unsigned a_lane(const Unit&, int, int R, unsigned c2) const { return (unsigned)(R * K * 2) + c2; }
    __device__ __forceinline__ const char* b_base(const Unit& u) const { return Bt + (size_t)u.pn * BM * K * 2; }
};
template <bool GATHER> struct MoeSched {
    static constexpr bool LANE_PER_UNIT = GATHER;

    const LAS int* pre; const LAS int* cntl; int ubeg, uend, G, c;
    const int* tokl; const char* A; const char* W; int K; size_t wstride;
    __device__ __forceinline__ bool next(int i, Unit& u) const {
        const int U = ubeg + i * G + c; if (U >= uend) return false;
        const int mg = U >> 2; const int lane = lane_here();
        const unsigned long long bal = __ballot(pre[lane] <= mg);
        const int g = __popcll(bal) - 1;
        u.pm = mg; u.pn = U & 3; u.g = g; u.mt = mg - pre[g]; return true;
    }
    __device__ __forceinline__ const char* a_ubase(const Unit& u) const { return GATHER ? A : A + (size_t)u.pm * BM * K * 2; }
    __device__ __forceinline__ size_t hstepA() const { return GATHER ? (size_t)0 : (size_t)HALF * K * 2; }
    __device__ __forceinline__ unsigned a_lane(const Unit& u, int h, int R, unsigned c2) const {
        if (GATHER) { const int cg = cntl[u.g]; const int rg = u.mt * BM + h * HALF + R; const int tok = tokl[(size_t)u.g * M + (rg < cg ? rg : 0)]; return (unsigned)tok * (unsigned)(K * 2) + c2; }
        return (unsigned)(R * K * 2) + c2;
    }
    __device__ __forceinline__ const char* b_base(const Unit& u) const { return W + (size_t)(u.g & 31) * wstride + (size_t)u.pn * BM * K * 2; }
};

template <class Epi, class Sched>
__device__ __forceinline__ void gemm_phase(LAS unsigned char* lds, const int Kc, const Sched& S, const Epi& E, const int wave0) {
    int K = Kc; asm volatile("" : "+s"(K));
    const int tid = opaque_tid(wave0), wid = __builtin_amdgcn_readfirstlane(tid >> 6), lane = tid & 63, wr = wid >> 2, wc = wid & 3, fr = lane & 15, fq = lane >> 4;
    const int nt = K / BK;
    unsigned voffB[2];
#pragma unroll
    for (int i = 0; i < 2; ++i) { int R, C; stage_rc(tid * 16 + i * 8192, R, C); const int Rb = Epi::PERM ? ((R & ~31) + perm32(R & 31)) : R;
        voffB[i] = (unsigned)(Rb * K + C) * 2u; }
#define PG8_ALANE(dst, unit) do { const int _t = opaque_tid(wave0); _Pragma("unroll") for (int _i = 0; _i < 2; ++_i) { int _R, _C; stage_rc(_t * 16 + _i * 8192, _R, _C); \
        _Pragma("unroll") for (int _h = 0; _h < 2; ++_h) dst[_h][_i] = S.a_lane(unit, _h, _R, (unsigned)_C * 2u); } } while (0)
    const size_t kstep = (size_t)(BK * 2);
    const size_t hstepB = (size_t)HALF * K * 2;
    const unsigned ldsw = (unsigned)wid * 1024u;
    const int aoff = lds_byte(wr * 64 + fr, fq * 8), boff = lds_byte(wc * 32 + fr, fq * 8);
#define PG8_SA(b, h) (((b) * 2 + (h)) * HTB)
#define PG8_SB(b, h) ((4 + (b) * 2 + (h)) * HTB)
#define PG8_STAGE_B(bufoff, gbase) do { _Pragma("unroll") for (int _i = 0; _i < 2; ++_i) { unsigned _o = voffB[_i]; asm volatile("" : "+v"(_o)); \
        __builtin_amdgcn_global_load_lds((const unsigned*)((const char*)(gbase) + _o), (LAS unsigned*)(lds + (bufoff) + ldsw + _i * 8192), 16, 0, 0); } } while (0)
#define PG8_STAGE_A(bufoff, gbase, offs) do { _Pragma("unroll") for (int _i = 0; _i < 2; ++_i) { unsigned _o = (offs)[_i]; asm volatile("" : "+v"(_o)); \
        __builtin_amdgcn_global_load_lds((const unsigned*)((const char*)(gbase) + _o), (LAS unsigned*)(lds + (bufoff) + ldsw + _i * 8192), 16, 0, 0); } } while (0)
#define PG8_LDA(dst, b, h) do { _Pragma("unroll") for (int m = 0; m < 4; ++m) { const bf16x8 _l = *(const LAS bf16x8*)(lds + PG8_SA(b, h) + aoff + m * 2048), _h = *(const LAS bf16x8*)(lds + PG8_SA(b, h) + aoff + m * 2048 + 1024); \
        dst[m] = __builtin_shufflevector(_l, _h, 0, 1, 2, 3, 4, 5, 6, 7, 8, 9, 10, 11, 12, 13, 14, 15); } } while (0)
#define PG8_LDB(dst, b, h) do { _Pragma("unroll") for (int n = 0; n < 2; ++n) { const bf16x8 _l = *(const LAS bf16x8*)(lds + PG8_SB(b, h) + boff + n * 2048), _h = *(const LAS bf16x8*)(lds + PG8_SB(b, h) + boff + n * 2048 + 1024); \
        dst[n] = __builtin_shufflevector(_l, _h, 0, 1, 2, 3, 4, 5, 6, 7, 8, 9, 10, 11, 12, 13, 14, 15); } } while (0)
#define PG8_LO(v) __builtin_shufflevector(v, v, 0, 1, 2, 3, 4, 5, 6, 7)
#define PG8_HI(v) __builtin_shufflevector(v, v, 8, 9, 10, 11, 12, 13, 14, 15)
#define PG8_MMA(ai, bj, At, Bt) do { __builtin_amdgcn_s_setprio(1); _Pragma("unroll") for (int m = 0; m < 4; ++m) _Pragma("unroll") for (int n = 0; n < 2; ++n) { \
        acc[ai][bj][m][n] = __builtin_amdgcn_mfma_f32_16x16x32_bf16(PG8_LO(Bt[n]), PG8_LO(At[m]), acc[ai][bj][m][n], 0, 0, 0); \
        acc[ai][bj][m][n] = __builtin_amdgcn_mfma_f32_16x16x32_bf16(PG8_HI(Bt[n]), PG8_HI(At[m]), acc[ai][bj][m][n], 0, 0, 0); } __builtin_amdgcn_s_setprio(0); } while (0)
#define PG8_MMA8(ai, bj, At, Bt) do { __builtin_amdgcn_s_setprio(1); _Pragma("unroll") for (int m = 0; m < 4; ++m) _Pragma("unroll") for (int n = 0; n < 2; ++n) { \
        acc[ai][bj][m][n] = __builtin_amdgcn_mfma_scale_f32_16x16x128_f8f6f4(__builtin_bit_cast(v8i, Bt[n]), __builtin_bit_cast(v8i, At[m]), acc[ai][bj][m][n], 0, 0, 0, 0x7f7f7f7f, 0, 0x7f7f7f7f); } __builtin_amdgcn_s_setprio(0); } while (0)
#define PG8_MM(ai, bj, At, Bt) do { if constexpr (Epi::F8) PG8_MMA8(ai, bj, At, Bt); else PG8_MMA(ai, bj, At, Bt); } while (0)
#define PG8_WAIT_V(n) asm volatile("s_waitcnt vmcnt(" #n ")" ::: "memory")
#define PG8_WAIT_V8_UNLESS(f) asm volatile("s_cmp_lg_u32 %0, 0\n\ts_cbranch_scc1 1f\n\ts_waitcnt vmcnt(8)\n1:" :: "s"(f) : "memory", "scc")
#define PG8_WAIT_L(n) asm volatile("s_waitcnt lgkmcnt(" #n ")" ::: "memory")
#define PG8_BAR __builtin_amdgcn_s_barrier()
#define PG8_SCHED __builtin_amdgcn_sched_barrier(0)
    Unit cur, nxt; int ui = 0;
    if (!S.next(0, cur)) return;
    const size_t hstepA = S.hstepA();
    unsigned coff[2][2], noff[2][2];
    PG8_ALANE(coff, cur);
    const char* cA = S.a_ubase(cur);
    const char* cB = S.b_base(cur);
    f32x4 acc[2][2][4][2];
#pragma unroll
    for (int a = 0; a < 2; ++a)
#pragma unroll
        for (int b = 0; b < 2; ++b)
#pragma unroll
            for (int m = 0; m < 4; ++m)
#pragma unroll
                for (int n = 0; n < 2; ++n) acc[a][b][m][n] = (f32x4){0.f, 0.f, 0.f, 0.f};
    s16x16 At[4], B0[2], B1[2];
    PG8_STAGE_B(PG8_SB(0, 0), cB); PG8_STAGE_B(PG8_SB(0, 1), cB + hstepB); PG8_STAGE_A(PG8_SA(0, 0), cA, coff[0]); PG8_STAGE_A(PG8_SA(0, 1), cA + hstepA, coff[1]);
    if (wr == 1) PG8_BAR;
    PG8_WAIT_V(2); PG8_BAR;
    PG8_STAGE_B(PG8_SB(1, 0), cB + kstep); PG8_STAGE_A(PG8_SA(1, 0), cA + kstep, coff[0]); PG8_STAGE_B(PG8_SB(1, 1), cB + hstepB + kstep);
    PG8_WAIT_V(6); PG8_BAR;
    int fast1 = 0;
    for (;;) {
        const bool has_next = S.next(ui + 1, nxt);
        const char* nB = cB; const char* nA = cA;
        if (has_next) {
            if constexpr (Sched::LANE_PER_UNIT) PG8_ALANE(noff, nxt);
            nB = S.b_base(nxt); nA = S.a_ubase(nxt);
        } else if constexpr (Sched::LANE_PER_UNIT) {
#pragma unroll
            for (int h = 0; h < 2; ++h)
#pragma unroll
                for (int i = 0; i < 2; ++i) noff[h][i] = coff[h][i];
        }
        int fz = fast1;
        for (int t = 0; t < nt; t += 2) {
            const bool last = (t == nt - 2); const int f1 = fz; fz = 0; asm volatile("" : "+s"(fz));
            const char* a1 = cA + (size_t)(t + 1) * kstep;
            const char* a2 = last ? nA : cA + (size_t)(t + 2) * kstep;
            const char* b2 = last ? nB : cB + (size_t)(t + 2) * kstep;
            const char* a3 = a2 + kstep; const char* b3 = b2 + kstep;
            PG8_LDB(B0, 0, 0); PG8_LDB(B1, 0, 1); PG8_SCHED; PG8_LDA(At, 0, 0); PG8_STAGE_A(PG8_SA(1, 1), a1 + hstepA, coff[1]);
            PG8_WAIT_V8_UNLESS(f1); PG8_WAIT_L(0); PG8_BAR; PG8_MM(0, 0, At, B0); PG8_MM(0, 1, At, B1); PG8_BAR; PG8_SCHED;
            if (Sched::LANE_PER_UNIT && last) {
#pragma unroll
                for (int h = 0; h < 2; ++h)
#pragma unroll
                    for (int i = 0; i < 2; ++i) coff[h][i] = noff[h][i];
            }
            PG8_LDA(At, 0, 1); PG8_STAGE_B(PG8_SB(0, 0), b2); PG8_STAGE_B(PG8_SB(0, 1), b2 + hstepB); PG8_STAGE_A(PG8_SA(0, 0), a2, coff[0]);
            PG8_WAIT_V8_UNLESS(f1); PG8_WAIT_L(0); PG8_BAR; PG8_MM(1, 0, At, B0); PG8_MM(1, 1, At, B1); PG8_BAR; PG8_SCHED;
            PG8_LDB(B0, 1, 0); PG8_LDB(B1, 1, 1); PG8_SCHED; PG8_LDA(At, 1, 0); PG8_STAGE_A(PG8_SA(0, 1), a2 + hstepA, coff[1]);
            PG8_WAIT_V8_UNLESS(f1); PG8_WAIT_L(0); PG8_BAR; PG8_MM(0, 0, At, B0); PG8_MM(0, 1, At, B1); PG8_BAR; PG8_SCHED;
            PG8_LDA(At, 1, 1); PG8_STAGE_B(PG8_SB(1, 0), b3); PG8_STAGE_B(PG8_SB(1, 1), b3 + hstepB); PG8_STAGE_A(PG8_SA(1, 0), a3, coff[0]);
            PG8_WAIT_V(8); PG8_WAIT_L(0); PG8_BAR; PG8_MM(1, 0, At, B0); PG8_MM(1, 1, At, B1); PG8_BAR; PG8_SCHED;
        }
        if (wr == 0) PG8_BAR;
        if (has_next) PG8_STAGE_A(PG8_SA(1, 1), nA + kstep + hstepA, coff[1]);
#ifdef STUB_EPI
        if (cur.pm == 12345) E(acc, cur, wr, wc, fr, fq); else { float q = 0.f; _Pragma("unroll") for (int a = 0; a < 2; ++a) _Pragma("unroll") for (int b = 0; b < 2; ++b) _Pragma("unroll") for (int m = 0; m < 4; ++m) _Pragma("unroll") for (int n = 0; n < 2; ++n) q += acc[a][b][m][n][0] + acc[a][b][m][n][1] + acc[a][b][m][n][2] + acc[a][b][m][n][3]; if (q == 1.2345f) ((float*)lds)[0] = q; }
#else
        { const int le = lane_here(); E(acc, cur, wr, wc, le & 15, le >> 4); }
#endif
        if (!has_next) break;
#pragma unroll
        for (int a = 0; a < 2; ++a)
#pragma unroll
            for (int b = 0; b < 2; ++b)
#pragma unroll
                for (int m = 0; m < 4; ++m)
#pragma unroll
                    for (int n = 0; n < 2; ++n) acc[a][b][m][n] = (f32x4){0.f, 0.f, 0.f, 0.f};
        cur = nxt; cB = nB; cA = nA; ++ui; fast1 = 1;
        if (wr == 1) PG8_BAR;
    }
    PG8_WAIT_V(0);
    PG8_BAR;
#undef PG8_ALANE
#undef PG8_SA
#undef PG8_SB
#undef PG8_STAGE_A
#undef PG8_STAGE_B
#undef PG8_LDA
#undef PG8_LDB
#undef PG8_LO
#undef PG8_HI
#undef PG8_MMA
#undef PG8_MMA8
#undef PG8_MM
#undef PG8_WAIT_V
#undef PG8_WAIT_L
#undef PG8_WAIT_V8_UNLESS
#undef PG8_BAR
#undef PG8_SCHED
}
}
using pg8::Unit;

__device__ __forceinline__ void up_bf16x8(const u32x4& w, f32x4& a, f32x4& b) {
    a = (f32x4){__builtin_bit_cast(float, w.x << 16), __builtin_bit_cast(float, w.x & 0xffff0000u), __builtin_bit_cast(float, w.y << 16), __builtin_bit_cast(float, w.y & 0xffff0000u)};
    b = (f32x4){__builtin_bit_cast(float, w.z << 16), __builtin_bit_cast(float, w.z & 0xffff0000u), __builtin_bit_cast(float, w.w << 16), __builtin_bit_cast(float, w.w & 0xffff0000u)};
}
__device__ __forceinline__ void ld_bf16x8(const bf16* p, f32x4& a, f32x4& b) {
    const u32x4 w = *(const u32x4*)p;
    a = (f32x4){__builtin_bit_cast(float, w.x << 16), __builtin_bit_cast(float, w.x & 0xffff0000u), __builtin_bit_cast(float, w.y << 16), __builtin_bit_cast(float, w.y & 0xffff0000u)};
    b = (f32x4){__builtin_bit_cast(float, w.z << 16), __builtin_bit_cast(float, w.z & 0xffff0000u), __builtin_bit_cast(float, w.w << 16), __builtin_bit_cast(float, w.w & 0xffff0000u)};
}
__device__ __forceinline__ void st_bf16x8(bf16* p, const f32x4& a, const f32x4& b) {
    u32x4 w; w.x = cvt_pk_bf16(a[0], a[1]); w.y = cvt_pk_bf16(a[2], a[3]); w.z = cvt_pk_bf16(b[0], b[1]); w.w = cvt_pk_bf16(b[2], b[3]);
    *(u32x4*)p = w;
}
__device__ __forceinline__ void st_bf16x4(bf16* p, const f32x4& a) { u32x2 w; w.x = cvt_pk_bf16(a[0], a[1]); w.y = cvt_pk_bf16(a[2], a[3]); *(u32x2*)p = w; }
__device__ __forceinline__ float sq8(const f32x4& a, const f32x4& b) { const f32x4 qa = a * a, qb = b * b; return ((qa[0] + qa[1]) + (qa[2] + qa[3])) + ((qb[0] + qb[1]) + (qb[2] + qb[3])); }
__device__ __forceinline__ float ss_row(const float* ss, int row) {
    const f32x4* p = (const f32x4*)(ss + (size_t)row * 16); const f32x4 a = p[0], b = p[1], c = p[2], d = p[3];
    return (((a[0] + a[1]) + (a[2] + a[3])) + ((b[0] + b[1]) + (b[2] + b[3]))) + (((c[0] + c[1]) + (c[2] + c[3])) + ((d[0] + d[1]) + (d[2] + d[3])));
}
__device__ __forceinline__ float ss_row4(const float* ss, int row, int fq) {
    const f32x4 a = *(const f32x4*)(ss + (size_t)row * 16 + 4 * fq); float s = (a[0] + a[1]) + (a[2] + a[3]);
    s += shx(s, 16); s += shx(s, 32); return s;
}
template <class T> __device__ __forceinline__ T ldo(const void* base, unsigned off) { return *(const T*)((const char*)base + off); }
template <class T> __device__ __forceinline__ void sto(void* base, unsigned off, const T& v) { *(T*)((char*)base + off) = v; }
__device__ __forceinline__ void sto_bf16x8(void* base, unsigned off, const f32x4& a, const f32x4& b) {
    u32x4 w; w.x = cvt_pk_bf16(a[0], a[1]); w.y = cvt_pk_bf16(a[2], a[3]); w.z = cvt_pk_bf16(b[0], b[1]); w.w = cvt_pk_bf16(b[2], b[3]); sto<u32x4>(base, off, w);
}
#define PIN1(x) asm volatile("" : "+v"(x))
#define PIN4(x) asm volatile("" : "+v"(x))
#define EPI_LOADS_DONE() do { asm volatile("s_waitcnt vmcnt(0)" ::: "memory"); __builtin_amdgcn_sched_barrier(0); } while (0)
#define EPI_FENCE() do { asm volatile("" ::: "memory"); __builtin_amdgcn_sched_barrier(0); } while (0)
__device__ __forceinline__ void rs_rows8(const float* ss, int rowb, int fq, float (&rs)[2][4], float post = 1.f) {
    const unsigned ob = (unsigned)rowb * 64u + 16u * (unsigned)fq; f32x4 a[2][4]; const int lh = lane_here(), x16 = (lh ^ 16) << 2, x32 = (lh ^ 32) << 2;
#pragma unroll
    for (int ai = 0; ai < 2; ++ai)
#pragma unroll
        for (int m = 0; m < 4; ++m) a[ai][m] = ldo<f32x4>(ss, ob + (unsigned)(ai * 128 + m * 16) * 64u);
#pragma unroll
    for (int ai = 0; ai < 2; ++ai)
#pragma unroll
        for (int m = 0; m < 4; ++m) { float q = (a[ai][m][0] + a[ai][m][1]) + (a[ai][m][2] + a[ai][m][3]);
            q += __builtin_bit_cast(float, __builtin_amdgcn_ds_bpermute(x16, __builtin_bit_cast(int, q))); q += __builtin_bit_cast(float, __builtin_amdgcn_ds_bpermute(x32, __builtin_bit_cast(int, q)));
            rs[ai][m] = rsqrtf(q + EPS * D) * (32.f * post); PIN1(rs[ai][m]); }
}
#define SS_STORE8(base, rowb_, slot_, v8) do { _Pragma("unroll") for (int _h = 0; _h < 2; ++_h) { const float _v = (fq == 0) ? (v8)[_h][0] : (fq == 1) ? (v8)[_h][1] : (fq == 2) ? (v8)[_h][2] : (v8)[_h][3]; \
        sto<float>((base), (((unsigned)(rowb_) + (unsigned)(_h * 128) + 16u * (unsigned)fq) * 16u + (unsigned)(slot_)) * 4u, _v); } } while (0)
#define ROWS8 _Pragma("unroll") for (int ai = 0; ai < 2; ++ai) _Pragma("unroll") for (int m = 0; m < 4; ++m)
#define RO(ai, m) ((unsigned)((ai) * 128 + (m) * 16))

struct EpiIn {
    static constexpr bool PERM = true, F8 = false;
    unsigned char* ws0; int l;
    __device__ __forceinline__ void operator()(f32x4 (&acc)[2][2][4][2], const Unit& u, int wr, int wc, int fr, int fq) const {
        unsigned char* ws = ws0; ws = GP(ws);
        const float* ss = (const float*)(ws + SS_MIX);
        const int pn = u.pn, rowb = u.pm * 256 + wr * 64 + fr;
        if (pn <= 2) {
            if (pn == 2 && wc >= 2) {
                float rs8[2][4]; rs_rows8(ss, rowb, fq, rs8); EPI_FENCE(); EPI_LOADS_DONE();
                const unsigned ob = (unsigned)rowb * 256u + (unsigned)((wc - 2) * 64 + 8 * fq) * 2u;
                ROWS8 {
#pragma unroll
                    for (int bj = 0; bj < 2; ++bj) sto_bf16x8(ws + WS_V, ob + RO(ai, m) * 256u + 64u * bj, acc[ai][bj][m][0] * rs8[ai][m], acc[ai][bj][m][1] * rs8[ai][m]); }
            } else {
                const float* gn = ((pn == 2) ? inp(6) : inp(5)) + l * 64; const float sc = (pn == 2) ? 1.f : 0.125f;
                const unsigned char* csT = ws + WS_MISC + MISC_COS;
                unsigned gh[2][2][2];
#pragma unroll
                for (int bj = 0; bj < 2; ++bj)
#pragma unroll
                    for (int n = 0; n < 2; ++n) { const f32x4 g = ldo<f32x4>(gn, (unsigned)(32 * bj + 8 * fq + 4 * n) * 4u);
#pragma unroll
                        for (int k = 0; k < 2; ++k) { h16x2 pr; pr[0] = (_Float16)g[2 * k]; pr[1] = (_Float16)g[2 * k + 1]; gh[bj][n][k] = __builtin_bit_cast(unsigned, pr); PIN1(gh[bj][n][k]); } }
                u32x4 pk[2][4][2];
                ROWS8 { f32x4 v[2][2]; u32x4 cs4[2]; float s2 = 0.f; float rs;
                    { const f32x4 a = ldo<f32x4>(ss, ((unsigned)rowb + RO(ai, m)) * 64u + 16u * (unsigned)fq); float q = (a[0] + a[1]) + (a[2] + a[3]); q += shx(q, 16); q += shx(q, 32); rs = rsqrtf(q + EPS * D) * 32.f; }
#pragma unroll
                    for (int n = 0; n < 2; ++n) cs4[n] = ldo<u32x4>(csT, ((unsigned)rowb + RO(ai, m)) * 32u + 16u * n);
#pragma unroll
                    for (int bj = 0; bj < 2; ++bj)
#pragma unroll
                        for (int n = 0; n < 2; ++n) { v[bj][n] = acc[ai][bj][m][n] * rs; const f32x4 q = v[bj][n] * v[bj][n]; s2 += (q[0] + q[1]) + (q[2] + q[3]); }
                    s2 += shx(s2, 16); s2 += shx(s2, 32);
                    const float hr = rsqrtf(s2 + EPS * 64.f) * (8.f * sc);
#pragma unroll
                    for (int bj = 0; bj < 2; ++bj)
#pragma unroll
                        for (int n = 0; n < 2; ++n) {
#pragma unroll
                            for (int k = 0; k < 2; ++k) { unsigned gw = gh[bj][n][k]; PIN1(gw); const h16x2 pr = __builtin_bit_cast(h16x2, gw);
                                v[bj][n][2 * k] = v[bj][n][2 * k] * hr * (float)pr[0]; v[bj][n][2 * k + 1] = v[bj][n][2 * k + 1] * hr * (float)pr[1]; } }
#pragma unroll
                    for (int n = 0; n < 2; ++n) {
#pragma unroll
                        for (int i = 0; i < 4; ++i) { const float x = v[0][n][i]; const float o = shx(x, 16); const unsigned cw = cs4[n][i]; const h16x2 pr = __builtin_bit_cast(h16x2, cw); const float cv = (float)pr[0], sv = (float)pr[1];
                            const float r0 = x * cv - o * sv, r1 = x * cv + o * sv;
                            v[0][n][i] = (fq == 0) ? r0 : ((fq == 1) ? r1 : x); } }
#pragma unroll
                    for (int bj = 0; bj < 2; ++bj) { u32x4 w; w.x = cvt_pk_bf16(v[bj][0][0], v[bj][0][1]); w.y = cvt_pk_bf16(v[bj][0][2], v[bj][0][3]); w.z = cvt_pk_bf16(v[bj][1][0], v[bj][1][1]); w.w = cvt_pk_bf16(v[bj][1][2], v[bj][1][3]);
                        PIN4(w); pk[ai][m][bj] = w; }
                    }
                EPI_FENCE(); EPI_LOADS_DONE();
                unsigned char* dst = (pn == 2) ? (ws + WS_K) : (ws + WS_Q); const unsigned pitch = (pn == 2) ? 256u : 1024u;
                const unsigned ob = (unsigned)rowb * pitch + (unsigned)(((pn == 2) ? wc : (4 * pn + wc)) * 64 + 8 * fq) * 2u;
                ROWS8 {
#pragma unroll
                    for (int bj = 0; bj < 2; ++bj) sto<u32x4>(dst, ob + RO(ai, m) * pitch + 64u * bj, pk[ai][m][bj]); }
            }
        } else {
            const int hd = (pn - 3) >> 1;
            const int cb0 = hd * 128 + 32 * wc + 8 * fq;
            const unsigned ob = (unsigned)rowb * 1024u + (unsigned)cb0 * 2u;
            float rs8[2][4]; rs_rows8(ss, rowb, fq, rs8);
            if (((pn - 3) & 1) == 0) {
                const float* lb = (const float*)(ws + WS_MISC + MISC_LB) + l * 512;
                const f32x4 lbv4[2] = {ldo<f32x4>(lb, (unsigned)cb0 * 4u), ldo<f32x4>(lb, (unsigned)cb0 * 4u + 16u)};
                EPI_FENCE(); EPI_LOADS_DONE();
#pragma unroll
                for (int ai = 0; ai < 2; ++ai) {
                    float chv[8];
                    unsigned qp[4][4], kp[4][4];
#pragma unroll
                    for (int n = 0; n < 2; ++n)
#pragma unroll
                        for (int ip = 0; ip < 2; ++ip) {
                            const int dcol = cb0 + 4 * n + 2 * ip; const float lb0 = lbv4[n][2 * ip], lb1 = lbv4[n][2 * ip + 1];
                            float qh[4][2], kh[4][2], ebr[2], ecc[2], edc[2];
#pragma unroll
                            for (int e = 0; e < 2; ++e) { const int i = 2 * ip + e; const float lbv = e ? lb1 : lb0;
                                float key[4], p[4], tot[4];
#pragma unroll
                                for (int m = 0; m < 4; ++m) { const float z = acc[ai][1][m][n][i] * rs8[ai][m]; const float t = fast_exp(-fmaxf(z, -30.f)), sg = __builtin_amdgcn_rcpf(1.f + t);
                                    key[m] = (1.f - lbv) * (t * sg); float v = __builtin_amdgcn_logf(lbv + (1.f - lbv) * sg) * 0.69314718f;
                                    v += __builtin_bit_cast(float, __builtin_amdgcn_update_dpp(0, __builtin_bit_cast(int, v), 0x111, 0xf, 0xf, true));
                                    v += __builtin_bit_cast(float, __builtin_amdgcn_update_dpp(0, __builtin_bit_cast(int, v), 0x112, 0xf, 0xf, true));
                                    v += __builtin_bit_cast(float, __builtin_amdgcn_update_dpp(0, __builtin_bit_cast(int, v), 0x114, 0xf, 0xf, true));
                                    v += __builtin_bit_cast(float, __builtin_amdgcn_update_dpp(0, __builtin_bit_cast(int, v), 0x118, 0xf, 0xf, true));
                                    p[m] = v; tot[m] = __builtin_bit_cast(float, __builtin_amdgcn_update_dpp(0, __builtin_bit_cast(int, v), 0x15F, 0xf, 0xf, false)); }
                                const float o1 = tot[0], o2 = o1 + tot[1], o3 = o2 + tot[2], blast = o3 + tot[3], bref = o2;
                                const float bb[4] = {p[0], p[1] + o1, p[2] + o2, p[3] + o3};
#pragma unroll
                                for (int m = 0; m < 4; ++m) { const float q = silu(acc[ai][0][m][n][i] * rs8[ai][m]);
                                    qh[m][e] = q * fast_exp(fminf(bb[m] - bref, 80.f)); kh[m][e] = key[m] * fast_exp(fminf(bref - bb[m], 80.f)); }
                                ebr[e] = fast_exp(bref); ecc[e] = fast_exp(blast - bref); edc[e] = fast_exp(blast); }
#pragma unroll
                            for (int m = 0; m < 4; ++m) { qp[m][2 * n + ip] = cvt_pk_bf16(qh[m][0], qh[m][1]); kp[m][2 * n + ip] = cvt_pk_bf16(kh[m][0], kh[m][1]); }
#pragma unroll
                            for (int e = 0; e < 2; ++e) chv[4 * n + 2 * ip + e] = (fr == 0) ? ebr[e] : ((fr == 1) ? ecc[e] : edc[e]);
                            EPI_FENCE();
                        }
                    if (fr < 3) { const unsigned co = (unsigned)((u.pm * 4 + ai * 2 + wr) * 512 + cb0) * 4u + (unsigned)fr * ((unsigned)(M / 64) * 2048u);
                        sto<f32x4>(ws + WS_CHS, co, (f32x4){chv[0], chv[1], chv[2], chv[3]}); sto<f32x4>(ws + WS_CHS, co + 16u, (f32x4){chv[4], chv[5], chv[6], chv[7]}); }
#pragma unroll
                    for (int m = 0; m < 4; ++m) { const unsigned go = ob + RO(ai, m) * 1024u;
                        sto<u32x4>(ws + WS_QR, go, (u32x4){qp[m][0], qp[m][1], qp[m][2], qp[m][3]}); sto<u32x4>(ws + WS_KEY, go, (u32x4){kp[m][0], kp[m][1], kp[m][2], kp[m][3]}); }
                }
            } else {
                EPI_FENCE(); EPI_LOADS_DONE();
                ROWS8 { const float rs = rs8[ai][m];
                    f32x4 a = acc[ai][1][m][0] * rs, b = acc[ai][1][m][1] * rs;
#pragma unroll
                    for (int i = 0; i < 4; ++i) { a[i] = silu(a[i]); b[i] = silu(b[i]); }
                    sto_bf16x8(ws + WS_IR, ob + RO(ai, m) * 1024u, acc[ai][0][m][0] * rs, acc[ai][0][m][1] * rs);
                    sto_bf16x8(ws + WS_GR, ob + RO(ai, m) * 1024u, a, b); }
            }
        }
    }
};

struct EpiResid {
    static constexpr bool PERM = true, F8 = true;
    unsigned char* ws0;
    __device__ __forceinline__ void operator()(f32x4 (&acc)[2][2][4][2], const Unit& u, int wr, int wc, int fr, int fq) const {
        unsigned char* ws = ws0; ws = GP(ws);
        const int rowb = u.pm * 256 + wr * 64 + fr, col0 = u.pn * 256 + wc * 64 + 8 * fq;
        const unsigned ob = ((unsigned)rowb * D + (unsigned)col0) * 2u;
#pragma unroll
        for (int ai = 0; ai < 2; ++ai) { u32x4 r[4][2];
#pragma unroll
            for (int m = 0; m < 4; ++m)
#pragma unroll
                for (int bj = 0; bj < 2; ++bj) r[m][bj] = ldo<u32x4>(ws + WS_HB, ob + RO(ai, m) * (D * 2u) + 64u * bj);
#pragma unroll
            for (int m = 0; m < 4; ++m)
#pragma unroll
                for (int bj = 0; bj < 2; ++bj) { f32x4 ra, rb; up_bf16x8(r[m][bj], ra, rb); acc[ai][bj][m][0] = acc[ai][bj][m][0] * (1.f / (MIX_SCALE * WOUT_SCALE)) + ra; acc[ai][bj][m][1] = acc[ai][bj][m][1] * (1.f / (MIX_SCALE * WOUT_SCALE)) + rb; PIN4(acc[ai][bj][m][0]); PIN4(acc[ai][bj][m][1]); } }
        EPI_FENCE(); EPI_LOADS_DONE();
        float ss8[2][4];
        ROWS8 { float s2 = 0.f; u32x2 f8[2];
#pragma unroll
            for (int bj = 0; bj < 2; ++bj) { const unsigned o = ob + RO(ai, m) * (D * 2u) + 64u * bj;
                const f32x4 va = acc[ai][bj][m][0], vb = acc[ai][bj][m][1]; sto_bf16x8(ws + WS_HB2, o, va, vb); f8[bj] = pk_fp8x8(va, vb); s2 += sq8(va, vb); }
            asm volatile("s_nop 3\n\tv_permlane16_swap_b32 %0, %2\n\ts_nop 1\n\tv_permlane16_swap_b32 %1, %3\n\ts_nop 3" : "+v"(f8[0].x), "+v"(f8[0].y), "+v"(f8[1].x), "+v"(f8[1].y));
            sto<u32x4>(ws + WS_HB2F8, ((ob + RO(ai, m) * (D * 2u)) >> 1) + ((fq & 1) ? 24u : 0u), (u32x4){f8[0].x, f8[0].y, f8[1].x, f8[1].y});
            s2 += shx(s2, 16); s2 += shx(s2, 32); ss8[ai][m] = s2; }
        SS_STORE8(ws + SS_FFN, rowb, u.pn * 4 + wc, ss8);
    }
};
struct EpiMoe1 {
    static constexpr bool PERM = true, F8 = true;
    unsigned char* ws0; const LAS int* cntl;
    __device__ __forceinline__ void operator()(f32x4 (&acc)[2][2][4][2], const Unit& u, int wr, int wc, int fr, int fq) const {
        unsigned char* ws = ws0; ws = GP(ws);
        const int cg = cntl[u.g]; const int rl0 = wr * 64 + fr;
        float rs8[2][4];
        {   int tok[2][4]; f32x4 a[2][4];
            ROWS8 { const int rg = u.mt * 256 + rl0 + (int)RO(ai, m); tok[ai][m] = ldo<int>(ws + WS_TOKL, (unsigned)(u.g * M + (rg < cg ? rg : 0)) * 4u); }
            ROWS8 a[ai][m] = ldo<f32x4>(ws + SS_FFN, (unsigned)tok[ai][m] * 64u + 16u * (unsigned)fq);
            ROWS8 { float q = (a[ai][m][0] + a[ai][m][1]) + (a[ai][m][2] + a[ai][m][3]); q += shx(q, 16); q += shx(q, 32); rs8[ai][m] = rsqrtf(q + EPS * D); PIN1(rs8[ai][m]); } }
        EPI_FENCE(); EPI_LOADS_DONE();
        const unsigned ob = (unsigned)(u.pm * 256 + rl0) * FF + (unsigned)(128 * u.pn + 32 * wc + 8 * fq);
#pragma unroll
        for (int ai = 0; ai < 2; ++ai)
#pragma unroll
            for (int mp = 0; mp < 2; ++mp) { u32x2 f8[2];
#pragma unroll
                for (int k = 0; k < 2; ++k) { const int m = 2 * mp + k; const float rs = rs8[ai][m], rh = __builtin_amdgcn_ldexpf(rs, 2)  ; f32x4 h0, h1;
#pragma unroll
                    for (int i = 0; i < 4; ++i) { h0[i] = clamp_f8(silu(acc[ai][0][m][0][i] * rs) * (acc[ai][1][m][0][i] * rh)); h1[i] = clamp_f8(silu(acc[ai][0][m][1][i] * rs) * (acc[ai][1][m][1][i] * rh)); }
                    f8[k] = pk_fp8x8(h0, h1); }
                asm volatile("s_nop 3\n\tv_permlane16_swap_b32 %0, %2\n\ts_nop 1\n\tv_permlane16_swap_b32 %1, %3\n\ts_nop 3" : "+v"(f8[0].x), "+v"(f8[0].y), "+v"(f8[1].x), "+v"(f8[1].y));
                const unsigned o = (fq & 1) ? (ob + RO(ai, 2 * mp + 1) * FF - 8u) : (ob + RO(ai, 2 * mp) * FF);
                sto<u32x4>(ws + WS_HID, o, (u32x4){f8[0].x, f8[0].y, f8[1].x, f8[1].y}); }
    }
};
struct EpiMoe2 {
    static constexpr bool PERM = true, F8 = true;
    unsigned char* ws0; const LAS int* cntl; bool FINAL;
    __device__ __forceinline__ void operator()(f32x4 (&acc)[2][2][4][2], const Unit& u, int wr, int wc, int fr, int fq) const {
        unsigned char* ws = ws0; ws = GP(ws);
        const int cg = cntl[u.g]; const int rl0 = wr * 64 + fr; const unsigned col0 = (unsigned)(u.pn * 256 + wc * 64 + 8 * fq);
        const unsigned d0c = col0 + ((fq & 1) ? 24u : 0u);
        int tok[2][4];
        if (!FINAL) {
            float w[2][4];
            ROWS8 { const int rg = u.mt * 256 + rl0 + (int)RO(ai, m); const unsigned li = (unsigned)(u.g * M + (rg < cg ? rg : 0)) * 4u; tok[ai][m] = ldo<int>(ws + WS_TOKL, li); w[ai][m] = ldo<float>(ws + WS_WL, li) * (16.f / (HID_SCALE * WD_SCALE)); }
            ROWS8 { PIN1(w[ai][m]); }
            EPI_FENCE(); EPI_LOADS_DONE();
            ROWS8 { const int rg = u.mt * 256 + rl0 + (int)RO(ai, m); u32x2 f8[2];
#pragma unroll
                for (int bj = 0; bj < 2; ++bj) { f32x4 va = acc[ai][bj][m][0] * w[ai][m], vb = acc[ai][bj][m][1] * w[ai][m];
#pragma unroll
                    for (int i = 0; i < 4; ++i) { va[i] = clamp_f8(va[i]); vb[i] = clamp_f8(vb[i]); }
                    f8[bj] = pk_fp8x8(va, vb); }
                asm volatile("s_nop 3\n\tv_permlane16_swap_b32 %0, %2\n\ts_nop 1\n\tv_permlane16_swap_b32 %1, %3\n\ts_nop 3" : "+v"(f8[0].x), "+v"(f8[0].y), "+v"(f8[1].x), "+v"(f8[1].y));
                if (rg < cg) sto<u32x4>(ws + WS_HB2F8, (unsigned)tok[ai][m] * D + d0c, (u32x4){f8[0].x, f8[0].y, f8[1].x, f8[1].y}); }
            return;
        }
#pragma unroll
        for (int ai = 0; ai < 2; ++ai) { float w[4]; u32x4 r[4][2], d[4];
#pragma unroll
            for (int m = 0; m < 4; ++m) { const int rg = u.mt * 256 + rl0 + (int)RO(ai, m); const unsigned li = (unsigned)(u.g * M + (rg < cg ? rg : 0)) * 4u; tok[ai][m] = ldo<int>(ws + WS_TOKL, li); w[m] = ldo<float>(ws + WS_WL, li) * (1.f / (HID_SCALE * WD_SCALE)); }
#pragma unroll
            for (int m = 0; m < 4; ++m) { d[m] = ldo<u32x4>(ws + WS_HB2F8, (unsigned)tok[ai][m] * D + d0c);
#pragma unroll
                for (int bj = 0; bj < 2; ++bj) r[m][bj] = ldo<u32x4>(ws + WS_HB2, ((unsigned)tok[ai][m] * D + col0) * 2u + 64u * bj); }
#pragma unroll
            for (int m = 0; m < 4; ++m) {
                asm volatile("s_nop 3\n\tv_permlane16_swap_b32 %0, %2\n\ts_nop 1\n\tv_permlane16_swap_b32 %1, %3\n\ts_nop 3" : "+v"(d[m].x), "+v"(d[m].y), "+v"(d[m].z), "+v"(d[m].w));
#pragma unroll
                for (int bj = 0; bj < 2; ++bj) { f32x4 ra, rb; up_bf16x8(r[m][bj], ra, rb); const unsigned q0 = bj ? d[m].z : d[m].x, q1 = bj ? d[m].w : d[m].y;
                    typedef float f32x2 __attribute__((ext_vector_type(2)));
                    const f32x2 e0 = __builtin_amdgcn_cvt_pk_f32_fp8((int)q0, false), e1 = __builtin_amdgcn_cvt_pk_f32_fp8((int)q0, true), e2 = __builtin_amdgcn_cvt_pk_f32_fp8((int)q1, false), e3 = __builtin_amdgcn_cvt_pk_f32_fp8((int)q1, true);
                    const f32x4 da = (f32x4){e0[0], e0[1], e1[0], e1[1]} * (1.f / 16.f), db = (f32x4){e2[0], e2[1], e3[0], e3[1]} * (1.f / 16.f);
                    acc[ai][bj][m][0] = (ra + da) + acc[ai][bj][m][0] * w[m]; acc[ai][bj][m][1] = (rb + db) + acc[ai][bj][m][1] * w[m]; PIN4(acc[ai][bj][m][0]); PIN4(acc[ai][bj][m][1]); } } }
        EPI_FENCE(); EPI_LOADS_DONE();
        ROWS8 { const int rg = u.mt * 256 + rl0 + (int)RO(ai, m); const bool valid = rg < cg; float s2 = 0.f;
            if (valid) {
#pragma unroll
                for (int bj = 0; bj < 2; ++bj) { const f32x4 va = acc[ai][bj][m][0], vb = acc[ai][bj][m][1]; sto_bf16x8(ws + WS_HB2, ((unsigned)tok[ai][m] * D + col0) * 2u + 64u * bj, va, vb); s2 += sq8(va, vb); }
            }
            s2 += shx(s2, 16); s2 += shx(s2, 32); if (fq == 0 && valid) sto<float>(ws + SS_PG, ((unsigned)tok[ai][m] * 16u + (unsigned)(u.pn * 4 + wc)) * 4u, s2); }
    }
};
struct EpiPle1 {
    static constexpr bool PERM = true, F8 = false;
    unsigned char* ws0;
    __device__ __forceinline__ void operator()(f32x4 (&acc)[2][2][4][2], const Unit& u, int wr, int wc, int fr, int fq) const {
        unsigned char* ws = ws0; ws = GP(ws);
        const int rowb = u.pm * 256 + wr * 64 + fr, col0 = u.pn * 256 + wc * 64 + 8 * fq;
        const unsigned ob = ((unsigned)rowb * D + (unsigned)col0) * 2u;
        EPI_LOADS_DONE();
        float ss8[2][4];
        ROWS8 { float s2 = 0.f;
#pragma unroll
            for (int bj = 0; bj < 2; ++bj) { const f32x4 a = acc[ai][bj][m][0], b = acc[ai][bj][m][1];
                sto_bf16x8(ws + WS_PLERAW, ob + RO(ai, m) * (D * 2u) + 64u * bj, a, b);
                const f32x4 qa = a * a, qb = b * b; s2 += (qa[0] + qa[1]) + (qa[2] + qa[3]) + (qb[0] + qb[1]) + (qb[2] + qb[3]); }
            s2 += shx(s2, 16); s2 += shx(s2, 32); ss8[ai][m] = s2; }
        SS_STORE8(ws + SS_PLE, rowb, u.pn * 4 + wc, ss8);
    }
};
struct EpiPle2 {
    static constexpr bool PERM = true, F8 = false;
    float* outf; unsigned char* ws0; int l;
    __device__ __forceinline__ void operator()(f32x4 (&acc)[2][2][4][2], const Unit& u, int wr, int wc, int fr, int fq) const {
        unsigned char* ws = ws0; ws = GP(ws);
        const float* pgain = inp(18) + l * D;
        const int rowb = u.pm * 256 + wr * 64 + fr, col0 = u.pn * 256 + wc * 64 + 8 * fq;
        const unsigned ob = ((unsigned)rowb * D + (unsigned)col0) * 2u;
        float r8[2][4]; rs_rows8((const float*)(ws + SS_PG), rowb, fq, r8);
        ROWS8 {
#pragma unroll
            for (int bj = 0; bj < 2; ++bj)
#pragma unroll
                for (int n = 0; n < 2; ++n) {
#pragma unroll
                    for (int i = 0; i < 4; ++i) acc[ai][bj][m][n][i] = __builtin_amdgcn_rcpf(1.f + fast_exp(-(acc[ai][bj][m][n][i] * r8[ai][m])));
                    PIN4(acc[ai][bj][m][n]); } }
        EPI_FENCE();
        rs_rows8((const float*)(ws + SS_PLE), rowb, fq, r8);
        f32x4 gn[2][2];
#pragma unroll
        for (int bj = 0; bj < 2; ++bj)
#pragma unroll
            for (int n = 0; n < 2; ++n) gn[bj][n] = ldo<f32x4>(pgain, (unsigned)(col0 + bj * 32 + 4 * n) * 4u);
        EPI_FENCE();
#pragma unroll
        for (int ai = 0; ai < 2; ++ai)
#pragma unroll
            for (int mh = 0; mh < 2; ++mh) { u32x4 rh[2][2], rr[2][2];
#pragma unroll
                for (int m2 = 0; m2 < 2; ++m2)
#pragma unroll
                    for (int bj = 0; bj < 2; ++bj) { const unsigned o = ob + RO(ai, 2 * mh + m2) * (D * 2u) + 64u * bj; rh[m2][bj] = ldo<u32x4>(ws + WS_HB2, o); rr[m2][bj] = ldo<u32x4>(ws + WS_PLERAW, o); }
#pragma unroll
                for (int m2 = 0; m2 < 2; ++m2) { const int m = 2 * mh + m2; const float rp = r8[ai][m];
#pragma unroll
                    for (int bj = 0; bj < 2; ++bj) { f32x4 ha, hb2, pa, pb; up_bf16x8(rh[m2][bj], ha, hb2); up_bf16x8(rr[m2][bj], pa, pb);
                        acc[ai][bj][m][0] = ha + (pa * rp * gn[bj][0]) * acc[ai][bj][m][0]; acc[ai][bj][m][1] = hb2 + (pb * rp * gn[bj][1]) * acc[ai][bj][m][1]; PIN4(acc[ai][bj][m][0]); PIN4(acc[ai][bj][m][1]); } }
                EPI_FENCE(); }
        EPI_LOADS_DONE();
        float ss8[2][4];
        ROWS8 { float s2 = 0.f;
#pragma unroll
            for (int bj = 0; bj < 2; ++bj) { const unsigned o = ob + RO(ai, m) * (D * 2u) + 64u * bj; const f32x4 ha = acc[ai][bj][m][0], hb2 = acc[ai][bj][m][1];
                if (outf) { sto<f32x4>(outf, o * 2u, ha); sto<f32x4>(outf, o * 2u + 16u, hb2); }
                else { sto_bf16x8(ws + WS_HB, o, ha, hb2); s2 += sq8(ha, hb2); } }
            s2 += shx(s2, 16); s2 += shx(s2, 32); ss8[ai][m] = s2; }
        if (!outf) SS_STORE8(ws + SS_MIX, rowb, u.pn * 4 + wc, ss8);
    }
};

struct Args { const float* in[21]; float* out; unsigned char* ws; int ph_lo, ph_hi; };

struct Ctx {
    LAS unsigned char* lds; int tid, lane, wave, G, c, vcu;
    float* h; unsigned char* ws;
};
__device__ __forceinline__ float wave_sum(float v) {
#pragma unroll
    for (int o = 1; o < 64; o <<= 1) v += shx(v, o);
    return v;
}

struct TrItem { const float* W; const float* gain; bf16* WT; int N, Kt, dst_row0, c0, c1, k0; float f8scale; };
__device__ __forceinline__ void tr_load(const TrItem& t, f32x4 (&v)[16], int lane) {
    const int r = lane >> 4, c = lane & 15; const int scol = (c < 8) ? (t.c0 + 4 * c) : (t.c1 + 4 * (c - 8));
#pragma unroll
    for (int i = 0; i < 16; ++i) v[i] = *(const f32x4*)(t.W + (size_t)(t.k0 + 4 * i + r) * t.N + scol);
}
__device__ __forceinline__ void tr_store(const TrItem& t, const f32x4 (&v)[16], LAS float* scr, int lane) {
    const int r = lane >> 4, c = lane & 15;
#pragma unroll
    for (int i = 0; i < 16; ++i) { LAS float* d = scr + (4 * i + r) * 65 + 4 * c; d[0] = v[i][0]; d[1] = v[i][1]; d[2] = v[i][2]; d[3] = v[i][3]; }
    asm volatile("s_waitcnt lgkmcnt(0)" ::: "memory");
    const int kc = lane & 7;
    f32x4 g0 = (f32x4){1.f, 1.f, 1.f, 1.f}, g1 = g0;
    if (t.gain) { g0 = *(const f32x4*)(t.gain + t.k0 + 8 * kc); g1 = *(const f32x4*)(t.gain + t.k0 + 8 * kc + 4); }
    if (t.f8scale != 0.f) { g0 = g0 * t.f8scale; g1 = g1 * t.f8scale; unsigned char* W8 = (unsigned char*)t.WT;
#pragma unroll
        for (int j = 0; j < 8; ++j) { const int n = (lane >> 3) + 8 * j; const LAS float* sp = scr + (8 * kc) * 65 + n;
            const f32x4 a = (f32x4){sp[0 * 65] * g0[0], sp[1 * 65] * g0[1], sp[2 * 65] * g0[2], sp[3 * 65] * g0[3]}, b = (f32x4){sp[4 * 65] * g1[0], sp[5 * 65] * g1[1], sp[6 * 65] * g1[2], sp[7 * 65] * g1[3]};
            *(u32x2*)(W8 + (size_t)(t.dst_row0 + n) * t.Kt + t.k0 + 8 * kc) = pk_fp8x8(a, b); }
    } else {
#pragma unroll
    for (int j = 0; j < 8; ++j) { const int n = (lane >> 3) + 8 * j; const LAS float* sp = scr + (8 * kc) * 65 + n;
        u32x4 o; o.x = cvt_pk_bf16(sp[0 * 65] * g0[0], sp[1 * 65] * g0[1]); o.y = cvt_pk_bf16(sp[2 * 65] * g0[2], sp[3 * 65] * g0[3]);
        o.z = cvt_pk_bf16(sp[4 * 65] * g1[0], sp[5 * 65] * g1[1]); o.w = cvt_pk_bf16(sp[6 * 65] * g1[2], sp[7 * 65] * g1[3]);
        *(u32x4*)(t.WT + (size_t)(t.dst_row0 + n) * t.Kt + t.k0 + 8 * kc) = o; }
    }
    asm volatile("s_waitcnt lgkmcnt(0)" ::: "memory");
}

__device__ __forceinline__ void prologue(Ctx& X) {
    unsigned char* ws = X.ws;
    const int tid = opaque_tid(X.wave), lane = tid & 63, wave = __builtin_amdgcn_readfirstlane(tid >> 6);
    LAS float* scr = (LAS float*)(X.lds + wave * 16640);
    const int gw = X.vcu * 8 + wave, NGW = X.G * 8;
    const float *w_in = inp(4), *w_out = inp(10), *w_gate = inp(14), *w_up = inp(15), *w_down = inp(16), *w_ple = inp(17), *w_pg = inp(20);
    const float *mix_norm = inp(3), *ffn_norm = inp(11), *pg_norm = inp(19);
    constexpr int I_IN = 16 * 44, I_OUT = 16 * 16, I_GU = 32 * 16 * 16, I_D = 32 * 8 * 16, I_PLE = 4 * 16, I_PG = 16 * 16;
    constexpr int I_LAYER = I_IN + I_OUT + I_GU + I_D + I_PLE + I_PG;
#define NCOL(gp) (256 * ((2 * (gp)) >> 3) + 64 * ((2 * (gp)) & 3) + 32 * (((2 * (gp)) >> 2) & 1))
    auto decode = [&](int it, TrItem& t) {
        const int l = it / I_LAYER; int r = it % I_LAYER;
        if (r < I_IN) { const int kb = r / 44, gp = r % 44, gi = 2 * gp, pn = gi >> 3, bj = (gi >> 2) & 1, wc = gi & 3;
            int sc, sc1;
            if (pn <= 2) { sc = 256 * pn + 64 * wc + 32 * bj; sc1 = sc + 64; }
            else { const int hd = (pn - 3) >> 1, tb = (pn - 3) & 1; sc = (tb ? (bj ? 2304 : 1792) : (bj ? 1280 : 768)) + hd * 128 + 32 * wc; sc1 = sc + 32; }
            t = TrItem{w_in + (size_t)l * D * IN_W, mix_norm + l * D, (bf16*)(ws + WS_WIN) + (size_t)l * IN_W * D, IN_W, D, 64 * gp, sc, sc1, 64 * kb, 0.f}; return; }
        r -= I_IN;
        if (r < I_OUT) { const int kb = r / 16, gp = r % 16;
            t = TrItem{w_out + (size_t)l * D * D, nullptr, (bf16*)(ws + WS_WOUT + (size_t)l * D * D), D, D, 64 * gp, NCOL(gp), NCOL(gp) + 64, 64 * kb, WOUT_SCALE}; return; }
        r -= I_OUT;
        if (r < I_GU) { const int e = r / 256, q = r % 256, kb = q / 16, gp = q % 16, gi = 2 * gp, pn = gi >> 3, bj = (gi >> 2) & 1, xg = gi & 3; const int sc = 128 * pn + 32 * xg;
            t = TrItem{(bj ? w_up : w_gate) + (size_t)(l * NEXP + e) * D * FF, ffn_norm + l * D, (bf16*)(ws + WS_WGU + (size_t)(l * NEXP + e) * 1024 * D), FF, D, 64 * gp, sc, sc + 32, 64 * kb, 32.f}; return; }
        r -= I_GU;
        if (r < I_D) { const int e = r / 128, q = r % 128, kb = q / 16, gp = q % 16;
            t = TrItem{w_down + (size_t)(l * NEXP + e) * FF * D, nullptr, (bf16*)(ws + WS_WD + (size_t)(l * NEXP + e) * D * FF), D, FF, 64 * gp, NCOL(gp), NCOL(gp) + 64, 64 * kb, WD_SCALE}; return; }
        r -= I_D;
        if (r < I_PLE) { const int kb = r / 16, gp = r % 16;
            t = TrItem{w_ple + (size_t)l * PLE * D, nullptr, (bf16*)(ws + WS_WPLE) + (size_t)l * D * PLE, D, PLE, 64 * gp, NCOL(gp), NCOL(gp) + 64, 64 * kb, 0.f}; return; }
        r -= I_PLE;
        { const int kb = r / 16, gp = r % 16;
            t = TrItem{w_pg + (size_t)l * D * D, pg_norm + l * D, (bf16*)(ws + WS_WPG) + (size_t)l * D * D, D, D, 64 * gp, NCOL(gp), NCOL(gp) + 64, 64 * kb, 0.f}; }
    };
    {
        f32x4 cur[16], nxt[16]; TrItem tc, tn; int it = gw;
        if (it < DEPTH * I_LAYER) { decode(it, tc); tr_load(tc, cur, lane); }
        while (it < DEPTH * I_LAYER) {
            const int itn = it + NGW; const bool more = itn < DEPTH * I_LAYER;
            if (more) { decode(itn, tn); tr_load(tn, nxt, lane); }
            tr_store(tc, cur, scr, lane);
            if (more) { tc = tn;
#pragma unroll
                for (int i = 0; i < 16; ++i) cur[i] = nxt[i]; }
            it = itn;
        }
    }
    const int gt = X.vcu * 512 + tid, NGT = X.G * 512;
    { const float *w_rg = inp(12), *w_re = inp(13); bf16* WR = (bf16*)(ws + WS_WR);
      for (int i = gt; i < DEPTH * 64 * D; i += NGT) { const int l = i / (64 * D), j = (i / D) % 64, k = i % D; float v = 0.f;
          if (j < 4) v = w_rg[((size_t)l * D + k) * 4 + j]; else if (j < 36) v = w_re[((size_t)l * D + k) * 32 + (j - 4)];
          WR[i] = (bf16)f2bf(v * ffn_norm[l * D + k]); } }
    { const f32x4* p4 = (const f32x4*)inp(1); u32x2* o = (u32x2*)(ws + WS_PB);
      for (size_t i = gt; i < (size_t)DEPTH * M * PLE / 4; i += NGT) { const f32x4 v = p4[i]; u32x2 w; w.x = pk2(v[0], v[1]); w.y = pk2(v[2], v[3]); o[i] = w; } }
    { const int* pos = (const int*)inp(2); float* cosT = (float*)(ws + WS_MISC + MISC_COS);
      for (int i = gt; i < M * 8; i += NGT) { const int j = i & 7; const int t = i >> 3;
          const double f = (j == 0) ? 1.0 : (j == 1) ? 0.19392274474868576 : (j == 2) ? 0.03760603093086393 : (j == 3) ? 0.007292664737217109 : (j == 4) ? 0.001414213562373095 : (j == 5) ? 0.0002742481756762073 : (j == 6) ? 5.318295896944988e-05 : 1.031338537721246e-05;
          const double x = (double)pos[t] * f; const double q = __builtin_rint(x * 0.6366197723675814); const double rr = (x - q * 1.5707963267948966) - q * 6.123233995736766e-17;
          const double r2 = rr * rr;
          double sn = rr * (1.0 + r2 * (-1.0 / 6 + r2 * (1.0 / 120 + r2 * (-1.0 / 5040 + r2 * (1.0 / 362880 + r2 * (-1.0 / 39916800 + r2 * (1.0 / 6227020800.0)))))));
          double cs = 1.0 + r2 * (-0.5 + r2 * (1.0 / 24 + r2 * (-1.0 / 720 + r2 * (1.0 / 40320 + r2 * (-1.0 / 3628800 + r2 * (1.0 / 479001600.0 + r2 * (-1.0 / 87178291200.0)))))));
          const int qi = (int)((long long)q & 3);
          const double s_ = (qi == 0) ? sn : (qi == 1) ? cs : (qi == 2) ? -sn : -cs;
          const double c_ = (qi == 0) ? cs : (qi == 1) ? -sn : (qi == 2) ? -cs : sn;
          h16x2 pr; pr[0] = (_Float16)(float)c_; pr[1] = (_Float16)(float)s_; ((unsigned*)cosT)[i] = __builtin_bit_cast(unsigned, pr); } }
    { const float* lbl = inp(8); float* LB = (float*)(ws + WS_MISC + MISC_LB);
      for (int i = gt; i < 512; i += NGT) { const float a0 = lbl[i], a1 = lbl[512 + i], a2 = lbl[1024 + i], a3 = lbl[1536 + i]; const float mx = fmaxf(fmaxf(a0, a1), fmaxf(a2, a3));
          const float e0 = __expf(a0 - mx), e1 = __expf(a1 - mx), e2 = __expf(a2 - mx), e3 = __expf(a3 - mx); const float inv = 1.f / (e0 + e1 + e2 + e3);
          LB[i] = 0.f; LB[512 + i] = e1 * inv; LB[1024 + i] = (e1 + e2) * inv; LB[1536 + i] = (e1 + e2 + e3) * inv; } }
    { const float* x = inp(0); bf16* HB = (bf16*)(ws + WS_HB); float* ss = (float*)(ws + SS_MIX);
      for (int m = gw; m < M; m += NGW) { const f32x4* xr = (const f32x4*)(x + (size_t)m * D) + lane; u32x2* br = (u32x2*)(HB + (size_t)m * D) + lane; float s = 0.f;
#pragma unroll
          for (int j = 0; j < 4; ++j) { const f32x4 v = xr[64 * j]; u32x2 w; w.x = pk2(v[0], v[1]); w.y = pk2(v[2], v[3]); br[64 * j] = w; s += (v[0] * v[0] + v[1] * v[1]) + (v[2] * v[2] + v[3] * v[3]); }
          s = wave_sum(s); if (lane < 16) ss[(size_t)m * 16 + lane] = (lane == 0) ? s : 0.f; } }
}

__device__ __forceinline__ int crow(int reg, int h) { return (reg & 3) + 8 * (reg >> 2) + 4 * h; }
__device__ __forceinline__ void tr_read2(unsigned a0, unsigned a1, s16x4& r0, s16x4& r1) {
    asm volatile("ds_read_b64_tr_b16 %0, %2\n\tds_read_b64_tr_b16 %1, %3\n\ts_waitcnt lgkmcnt(0)" : "=&v"(r0), "=&v"(r1) : "v"(a0), "v"(a1) : "memory");
}
__device__ __forceinline__ void attn_phase(Ctx& X, int layer) {
    const bf16* Q = (const bf16*)(X.ws + WS_Q); const bf16* Kb = (const bf16*)(X.ws + WS_K); const bf16* Vb = (const bf16*)(X.ws + WS_V); bf16* MIX = (bf16*)(X.ws + WS_MIX);
    const float* sinks = inp(7) + layer * 8;
    LAS bf16* Ks = (LAS bf16*)X.lds; LAS bf16* Vs = (LAS bf16*)(X.lds + 36864);
    const unsigned vs_base = (unsigned)(size_t)Vs;
    const int tid = opaque_tid(X.wave), lane = tid & 63, wid = __builtin_amdgcn_readfirstlane(tid >> 6), r = lane & 31, hh = lane >> 5;
    const int tq = (lane & 15) >> 2, tp = lane & 3, dsub = (lane >> 4) & 1;
#pragma unroll 1
    for (int unit = X.c; unit < 512; unit += X.G) {
        const int b = unit >> 7, rem = unit & 127, nblk = rem >> 1, kvh = rem & 1;
        const int m0 = b * SEQ + nblk * 128;
        __syncthreads();
#pragma unroll
        for (int j = 0; j < 4; ++j) { const int idx = tid + 512 * j, key = idx >> 3, ch = idx & 7; const bool valid = (nblk > 0) || (key >= 128);
            u32x4 kv = (u32x4){0u, 0u, 0u, 0u}, vv = (u32x4){0u, 0u, 0u, 0u};
            if (valid) { const size_t o = (size_t)(m0 - 128 + key) * 128 + kvh * 64 + ch * 8; kv = *(const u32x4*)(Kb + o); vv = *(const u32x4*)(Vb + o); }
            *(LAS u32x4*)(Ks + key * 72 + ch * 8) = kv; *(LAS u32x4*)(Vs + key * 72 + ch * 8) = vv; }
        __syncthreads();
#pragma unroll 1
        for (int tt = 0; tt < 2; ++tt) {
            const int task = wid + 8 * tt, hl = task & 3, qs = task >> 2, hq = kvh * 4 + hl;
            const float sink = sinks[hq];
            bf16x8 qf[4];
#pragma unroll
            for (int ks = 0; ks < 4; ++ks) qf[ks] = *(const bf16x8*)(Q + (size_t)(m0 + 32 * qs + r) * 512 + hq * 64 + 16 * ks + 8 * hh);
            f32x16 s[5];
#pragma unroll
            for (int kt = 0; kt < 5; ++kt) {
#pragma unroll
                for (int i = 0; i < 16; ++i) s[kt][i] = 0.f;
#pragma unroll
                for (int ks = 0; ks < 4; ++ks) { const bf16x8 kf = *(const LAS bf16x8*)(Ks + (32 * (qs + kt) + r) * 72 + 16 * ks + 8 * hh); s[kt] = MFMA32(kf, qf[ks], s[kt]); }
            }
            const int qi = 32 * qs + r; float mx = sink;
#pragma unroll
            for (int kt = 0; kt < 5; ++kt)
#pragma unroll
                for (int i = 0; i < 16; ++i) { const int kj = 32 * (qs + kt) + crow(i, hh); const bool ok = (kj > qi) && (kj <= qi + 128) && ((nblk > 0) || (kj >= 128));
                    const float v = ok ? s[kt][i] : -1e30f; s[kt][i] = v; mx = fmaxf(mx, v); }
            mx = fmaxf(mx, shx(mx, 32));
            float sum = 0.f;
#pragma unroll
            for (int kt = 0; kt < 5; ++kt)
#pragma unroll
                for (int i = 0; i < 16; ++i) { const float e = fast_exp(s[kt][i] - mx); s[kt][i] = e; sum += e; }
            sum += shx(sum, 32);
            const float inv = __builtin_amdgcn_rcpf(sum + fast_exp(sink - mx));
            f32x16 o[2];
#pragma unroll
            for (int i = 0; i < 16; ++i) { o[0][i] = 0.f; o[1][i] = 0.f; }
#pragma unroll
            for (int kt = 0; kt < 5; ++kt)
#pragma unroll
                for (int st = 0; st < 2; ++st) {
                    u32x4 pw; pw.x = cvt_pk_bf16(s[kt][8 * st + 0], s[kt][8 * st + 1]); pw.y = cvt_pk_bf16(s[kt][8 * st + 2], s[kt][8 * st + 3]);
                    pw.z = cvt_pk_bf16(s[kt][8 * st + 4], s[kt][8 * st + 5]); pw.w = cvt_pk_bf16(s[kt][8 * st + 6], s[kt][8 * st + 7]);
                    const bf16x8 pb = __builtin_bit_cast(bf16x8, pw);
                    const int key0 = 32 * (qs + kt) + 16 * st + 4 * hh;
#pragma unroll
                    for (int nt = 0; nt < 2; ++nt) { s16x4 lo, hi; const unsigned va = vs_base + (unsigned)((key0 + tq) * 72 + 32 * nt + 16 * dsub + 4 * tp) * 2u;
                        tr_read2(va, va + 8 * 72 * 2, lo, hi);
                        const bf16x8 vt = __builtin_shufflevector(lo, hi, 0, 1, 2, 3, 4, 5, 6, 7);
                        o[nt] = MFMA32(vt, pb, o[nt]); }
                }
            unsigned char* orow = (unsigned char*)MIX + (size_t)(m0 + 32 * qs + r) * D + hq * 64 + 8 * hh;
            const float invs = __builtin_amdgcn_ldexpf(inv, 2)  ;
#pragma unroll
            for (int nt = 0; nt < 2; ++nt)
#pragma unroll
                for (int gp = 0; gp < 2; ++gp) { const int g0 = 2 * gp, g1 = 2 * gp + 1;
                    int wa = __builtin_amdgcn_cvt_pk_fp8_f32(clamp_f8(o[nt][4 * g0] * invs), clamp_f8(o[nt][4 * g0 + 1] * invs), 0, false); wa = __builtin_amdgcn_cvt_pk_fp8_f32(clamp_f8(o[nt][4 * g0 + 2] * invs), clamp_f8(o[nt][4 * g0 + 3] * invs), wa, true);
                    int wb = __builtin_amdgcn_cvt_pk_fp8_f32(clamp_f8(o[nt][4 * g1] * invs), clamp_f8(o[nt][4 * g1 + 1] * invs), 0, false); wb = __builtin_amdgcn_cvt_pk_fp8_f32(clamp_f8(o[nt][4 * g1 + 2] * invs), clamp_f8(o[nt][4 * g1 + 3] * invs), wb, true);
                    asm volatile("s_nop 3\n\tv_permlane32_swap_b32 %0, %1\n\ts_nop 3" : "+v"(wa), "+v"(wb));
                    *(u32x2*)(orow + 32 * nt + 16 * gp) = (u32x2){(unsigned)wa, (unsigned)wb}; }
        }
    }
}

constexpr int HG_P = 136;
constexpr int HG_QH = 0, HG_KH = 17408, HG_V = 34816, HG_AL = 52224, HG_OL = 61440, HG_SC = 95232;
__device__ __forceinline__ void tr_read4(unsigned a0, unsigned a1, unsigned a2, unsigned a3, s16x4& r0, s16x4& r1, s16x4& r2, s16x4& r3) {
    asm volatile("ds_read_b64_tr_b16 %0, %4\n\tds_read_b64_tr_b16 %1, %5\n\tds_read_b64_tr_b16 %2, %6\n\tds_read_b64_tr_b16 %3, %7\n\ts_waitcnt lgkmcnt(0)"
                 : "=&v"(r0), "=&v"(r1), "=&v"(r2), "=&v"(r3) : "v"(a0), "v"(a1), "v"(a2), "v"(a3) : "memory");
}
template <bool PASS2>
__device__ __forceinline__ void hgrn_pass(Ctx& X, int layer) {
    const bf16* QHg = (const bf16*)(X.ws + WS_QR); const bf16* KHg = (const bf16*)(X.ws + WS_KEY); const bf16* Vg = (const bf16*)(X.ws + WS_IR); const bf16* GR = (const bf16*)(X.ws + WS_GR);
    const float* CHS = (const float*)(X.ws + WS_CHS); float* USUP = (float*)(X.ws + WS_USUP); float* DSUP = (float*)(X.ws + WS_MISC + MISC_DSUP); bf16* MIX = (bf16*)(X.ws + WS_MIX);
    const float* rnorm = inp(9) + layer * 128;
    LAS unsigned char* lds = X.lds;
    LAS bf16* QHs = (LAS bf16*)(lds + HG_QH); LAS bf16* KHs = (LAS bf16*)(lds + HG_KH); LAS bf16* Vs = (LAS bf16*)(lds + HG_V); LAS bf16* AL = (LAS bf16*)(lds + HG_AL);
    LAS float* OL = (LAS float*)(lds + HG_OL); LAS float* SC = (LAS float*)(lds + HG_SC);
    const int tid = opaque_tid(X.wave), lane = tid & 63, wid = __builtin_amdgcn_readfirstlane(tid >> 6), r16 = lane & 15, g4 = lane >> 4;
    const int prow = tid >> 4, pc16 = tid & 15;
    const unsigned vs_base = (unsigned)(size_t)Vs, kh_base = (unsigned)(size_t)KHs;
    const int tq = (lane & 15) >> 2, tp = lane & 3;
#pragma unroll 1
    for (int unit = X.c; unit < 512; unit += X.G) {
        const int bh = unit >> 5, sc = unit & 31, b = bh >> 2, hd = bh & 3;
        const int m0 = b * SEQ + sc * 256, cb = hd * 128;
        f32x4 S[8];
#pragma unroll
        for (int mt = 0; mt < 8; ++mt) S[mt] = (f32x4){0.f, 0.f, 0.f, 0.f};
        if (PASS2 && sc > 0) {
#pragma unroll
            for (int mt = 0; mt < 8; ++mt) S[mt] = *(const f32x4*)(USUP + ((size_t)unit * 128 + 16 * wid + r16) * 128 + 16 * mt + 4 * g4);
        }
        float dprod = 1.f;
        u32x4 pq[2], pk[2], pv[2]; float psc[3] = {0.f, 0.f, 0.f};
        {
            const size_t g0 = (size_t)(m0 + prow) * 512 + cb + 8 * pc16, g1 = g0 + (size_t)32 * 512;
            pk[0] = *(const u32x4*)(KHg + g0); pk[1] = *(const u32x4*)(KHg + g1); pv[0] = *(const u32x4*)(Vg + g0); pv[1] = *(const u32x4*)(Vg + g1);
            if (PASS2) { pq[0] = *(const u32x4*)(QHg + g0); pq[1] = *(const u32x4*)(QHg + g1); }
            if (tid < 128) { const size_t co = (size_t)(m0 >> 6) * 512 + cb + tid;
#pragma unroll
                for (int k = 0; k < 3; ++k) psc[k] = CHS[(size_t)k * (M / 64) * 512 + co]; }
        }
        __syncthreads();
#pragma unroll 1
        for (int ch = 0; ch < 4; ++ch) {
            const int row0 = m0 + 64 * ch;
            *(LAS u32x4*)(KHs + prow * HG_P + 8 * pc16) = pk[0]; *(LAS u32x4*)(KHs + (prow + 32) * HG_P + 8 * pc16) = pk[1];
            *(LAS u32x4*)(Vs + prow * HG_P + 8 * pc16) = pv[0]; *(LAS u32x4*)(Vs + (prow + 32) * HG_P + 8 * pc16) = pv[1];
            if (PASS2) { *(LAS u32x4*)(QHs + prow * HG_P + 8 * pc16) = pq[0]; *(LAS u32x4*)(QHs + (prow + 32) * HG_P + 8 * pc16) = pq[1]; }
            if (tid < 128) { SC[tid] = psc[0]; SC[128 + tid] = psc[1]; SC[256 + tid] = psc[2]; dprod *= psc[2]; }
            __syncthreads();
            if (ch < 3) {
                const size_t g0 = (size_t)(row0 + 64 + prow) * 512 + cb + 8 * pc16, g1 = g0 + (size_t)32 * 512;
                pk[0] = *(const u32x4*)(KHg + g0); pk[1] = *(const u32x4*)(KHg + g1); pv[0] = *(const u32x4*)(Vg + g0); pv[1] = *(const u32x4*)(Vg + g1);
                if (PASS2) { pq[0] = *(const u32x4*)(QHg + g0); pq[1] = *(const u32x4*)(QHg + g1); }
                if (tid < 128) { const size_t co = (size_t)((row0 + 64) >> 6) * 512 + cb + tid;
#pragma unroll
                    for (int k = 0; k < 3; ++k) psc[k] = CHS[(size_t)k * (M / 64) * 512 + co]; }
            }
            bf16x8 vf[2];
            { s16x4 a0, a1, a2, a3; const unsigned va = vs_base + (unsigned)((8 * g4 + tq) * HG_P + 16 * wid + 4 * tp) * 2u;
              tr_read4(va, va + 4 * HG_P * 2, va + 32 * HG_P * 2, va + 36 * HG_P * 2, a0, a1, a2, a3);
              vf[0] = __builtin_shufflevector(a0, a1, 0, 1, 2, 3, 4, 5, 6, 7); vf[1] = __builtin_shufflevector(a2, a3, 0, 1, 2, 3, 4, 5, 6, 7); }
            if (PASS2) {
#pragma unroll
                for (int q2 = 0; q2 < 2; ++q2) { const int tile = 2 * wid + q2, ti = tile >> 2, si = tile & 3; f32x4 a4 = (f32x4){0.f, 0.f, 0.f, 0.f};
                    if (si <= ti) {
#pragma unroll
                        for (int ks = 0; ks < 4; ++ks) { const bf16x8 af = *(const LAS bf16x8*)(QHs + (16 * ti + r16) * HG_P + 32 * ks + 8 * g4), bfr = *(const LAS bf16x8*)(KHs + (16 * si + r16) * HG_P + 32 * ks + 8 * g4); a4 = MFMA16(af, bfr, a4); }
                    }
#pragma unroll
                    for (int rg = 0; rg < 4; ++rg) { const int t = 16 * ti + 4 * g4 + rg, s_ = 16 * si + r16; AL[t * 72 + s_] = (bf16)f2bf((s_ <= t) ? a4[rg] : 0.f); } }
                __syncthreads();
                f32x4 o[4];
#pragma unroll
                for (int mt = 0; mt < 4; ++mt) { o[mt] = (f32x4){0.f, 0.f, 0.f, 0.f};
#pragma unroll
                    for (int ks = 0; ks < 2; ++ks) { const bf16x8 af = *(const LAS bf16x8*)(AL + (16 * mt + r16) * 72 + 32 * ks + 8 * g4); o[mt] = MFMA16(af, vf[ks], o[mt]); } }
#pragma unroll
                for (int k2 = 0; k2 < 4; ++k2) { const f32x4 e0 = *(const LAS f32x4*)(SC + 32 * k2 + 4 * g4), e1 = *(const LAS f32x4*)(SC + 32 * k2 + 16 + 4 * g4);
                    const f32x4 s0 = S[2 * k2] * e0, s1 = S[2 * k2 + 1] * e1;
                    u32x4 sw; sw.x = cvt_pk_bf16(s0[0], s0[1]); sw.y = cvt_pk_bf16(s0[2], s0[3]); sw.z = cvt_pk_bf16(s1[0], s1[1]); sw.w = cvt_pk_bf16(s1[2], s1[3]);
                    const bf16x8 sb = __builtin_bit_cast(bf16x8, sw);
#pragma unroll
                    for (int mt = 0; mt < 4; ++mt) { const LAS bf16* qp = QHs + (16 * mt + r16) * HG_P + 32 * k2 + 4 * g4; const s16x4 lo = *(const LAS s16x4*)qp, hi = *(const LAS s16x4*)(qp + 16);
                        const bf16x8 af = __builtin_shufflevector(lo, hi, 0, 1, 2, 3, 4, 5, 6, 7); o[mt] = MFMA16(af, sb, o[mt]); } }
#pragma unroll
                for (int mt = 0; mt < 4; ++mt)
#pragma unroll
                    for (int rg = 0; rg < 4; ++rg) OL[(16 * mt + 4 * g4 + rg) * 132 + 16 * wid + r16] = o[mt][rg];
            }
#pragma unroll
            for (int mt = 0; mt < 8; ++mt) { s16x4 a0, a1, a2, a3; const unsigned ka = kh_base + (unsigned)((8 * g4 + tq) * HG_P + 16 * mt + 4 * tp) * 2u;
                tr_read4(ka, ka + 4 * HG_P * 2, ka + 32 * HG_P * 2, ka + 36 * HG_P * 2, a0, a1, a2, a3);
                const bf16x8 k0 = __builtin_shufflevector(a0, a1, 0, 1, 2, 3, 4, 5, 6, 7), k1 = __builtin_shufflevector(a2, a3, 0, 1, 2, 3, 4, 5, 6, 7);
                f32x4 T = (f32x4){0.f, 0.f, 0.f, 0.f}; T = MFMA16(k0, vf[0], T); T = MFMA16(k1, vf[1], T);
                const f32x4 ccv = *(const LAS f32x4*)(SC + 128 + 16 * mt + 4 * g4), dcv = *(const LAS f32x4*)(SC + 256 + 16 * mt + 4 * g4);
                S[mt] = S[mt] * dcv + T * ccv; }
            __syncthreads();
            if (PASS2) {
                const int t = tid >> 3, e0 = (tid & 7) * 16; f32x4 v[4]; float s2 = 0.f;
#pragma unroll
                for (int j = 0; j < 4; ++j) { v[j] = *(const LAS f32x4*)(OL + t * 132 + e0 + 4 * j); const f32x4 q = v[j] * v[j]; s2 += (q[0] + q[1]) + (q[2] + q[3]); }
                s2 += shx(s2, 1); s2 += shx(s2, 2); s2 += shx(s2, 4);
                const float rs = rsqrtf(s2 + EPS * 128.f) * 11.313708499f;
                const size_t go = (size_t)(row0 + t) * 512 + cb + e0;
                f32x4 ga, gb, gc, gd; ld_bf16x8(GR + go, ga, gb); ld_bf16x8(GR + go + 8, gc, gd);
                const f32x4 r0 = *(const f32x4*)(rnorm + e0), r1 = *(const f32x4*)(rnorm + e0 + 4), r2 = *(const f32x4*)(rnorm + e0 + 8), r3 = *(const f32x4*)(rnorm + e0 + 12);
                unsigned char* dst = (unsigned char*)MIX + (size_t)(row0 + t) * D + 512 + cb + e0;
                const float rss = __builtin_amdgcn_ldexpf(rs, 2)  ; f32x4 y[4] = {v[0] * rss * r0 * ga, v[1] * rss * r1 * gb, v[2] * rss * r2 * gc, v[3] * rss * r3 * gd};
#pragma unroll
                for (int j = 0; j < 4; ++j)
#pragma unroll
                    for (int i = 0; i < 4; ++i) y[j][i] = clamp_f8(y[j][i]);
                const u32x2 w0 = pk_fp8x8(y[0], y[1]), w1 = pk_fp8x8(y[2], y[3]);
                *(u32x4*)dst = (u32x4){w0.x, w0.y, w1.x, w1.y};
            }
        }
        if (!PASS2) {
#pragma unroll
            for (int mt = 0; mt < 8; ++mt) *(f32x4*)(USUP + ((size_t)unit * 128 + 16 * wid + r16) * 128 + 16 * mt + 4 * g4) = S[mt];
            if (tid < 128) DSUP[unit * 128 + tid] = dprod;
        }
    }
}
__device__ __forceinline__ void hgrn_scan(Ctx& X) {
    float* USUP = (float*)(X.ws + WS_USUP); const float* DSUP = (const float*)(X.ws + WS_MISC + MISC_DSUP);
    const int tid = opaque_tid(X.wave);
    for (int item = X.c * 512 + tid; item < 16 * 4096; item += X.G * 512) {
        const int bh = item >> 12, idx = item & 4095, e = idx >> 5, dk4 = (idx & 31) * 4;
        f32x4 s = (f32x4){0.f, 0.f, 0.f, 0.f};
        for (int s0 = 0; s0 < 32; s0 += 8) {
            f32x4 uv[8], dv[8];
#pragma unroll
            for (int j = 0; j < 8; ++j) { const int u = bh * 32 + s0 + j; uv[j] = *(const f32x4*)(USUP + ((size_t)u * 128 + e) * 128 + dk4); dv[j] = *(const f32x4*)(DSUP + u * 128 + dk4); }
#pragma unroll
            for (int j = 0; j < 8; ++j) { const int u = bh * 32 + s0 + j; *(f32x4*)(USUP + ((size_t)u * 128 + e) * 128 + dk4) = s; s = s * dv[j] + uv[j]; }
        }
    }
}

__device__ __forceinline__ void router_phase(Ctx& X, int layer) {
    const bf16* HB = (const bf16*)(X.ws + WS_HB2); const bf16* WR = (const bf16*)(X.ws + WS_WR) + (size_t)layer * 64 * D;
    const float* ssf = (const float*)(X.ws + SS_FFN);
    unsigned* CNT = (unsigned*)(X.ws + WS_CTL) + CW_CNT; int* TOKL = (int*)(X.ws + WS_TOKL); float* WL = (float*)(X.ws + WS_WL);
    LAS bf16* WRs = (LAS bf16*)X.lds;
    LAS float* LOG = (LAS float*)(X.lds + 99328);
    LAS unsigned* HIST = (LAS unsigned*)(X.lds + 124672); LAS unsigned* BASE = (LAS unsigned*)(X.lds + 124928);
    const int tid = opaque_tid(X.wave), lane = tid & 63, wid = __builtin_amdgcn_readfirstlane(tid >> 6), r16 = lane & 15, g4 = lane >> 4;
    __syncthreads();
#pragma unroll
    for (int j = 0; j < 12; ++j) { const int p = tid + 512 * j, row = p >> 7, c16 = p & 127; *(LAS u32x4*)(WRs + row * 1032 + 8 * c16) = *(const u32x4*)(WR + (size_t)row * D + 8 * c16); }
    __syncthreads();
    for (int bt = X.c; bt < M / 128; bt += X.G) {
        const int tok0 = bt * 128 + wid * 16;
        f32x4 acc[3];
#pragma unroll
        for (int nt = 0; nt < 3; ++nt) acc[nt] = (f32x4){0.f, 0.f, 0.f, 0.f};
#pragma unroll 1
        for (int kh = 0; kh < 2; ++kh) { bf16x8 a[16];
#pragma unroll
            for (int k = 0; k < 16; ++k) a[k] = *(const bf16x8*)(HB + (size_t)(tok0 + r16) * D + 32 * (16 * kh + k) + 8 * g4);
#pragma unroll
            for (int k = 0; k < 16; ++k)
#pragma unroll
                for (int nt = 0; nt < 3; ++nt) { const bf16x8 bq = *(const LAS bf16x8*)(WRs + (16 * nt + r16) * 1032 + 32 * (16 * kh + k) + 8 * g4); acc[nt] = MFMA16(a[k], bq, acc[nt]); } }
#pragma unroll
        for (int nt = 0; nt < 3; ++nt)
#pragma unroll
            for (int rg = 0; rg < 4; ++rg) LOG[(wid * 16 + 4 * g4 + rg) * 49 + 16 * nt + r16] = acc[nt][rg];
        if (tid < 64) HIST[tid] = 0u;
        __syncthreads();
        int G0 = 0, G1 = 0; unsigned lr0 = 0, lr1 = 0; float w0 = 0.f, w1 = 0.f; const int tok = tok0 + lane;
        if (lane < 16) {
            const LAS float* lg = LOG + (wid * 16 + lane) * 49; const float rs = rsqrtf(ss_row(ssf, tok) + EPS * D) * 32.f;
            float gl[4];
#pragma unroll
            for (int j = 0; j < 4; ++j) gl[j] = lg[j] * rs;
            int gi = 0; float gm = gl[0];
#pragma unroll
            for (int j = 1; j < 4; ++j) if (gl[j] > gm) { gm = gl[j]; gi = j; }
            float gs = 0.f;
#pragma unroll
            for (int j = 0; j < 4; ++j) gs += __expf(gl[j] - gm);
            const float pg = 1.f / gs;
            const LAS float* le = lg + 4 + 8 * gi;
            float el[8];
#pragma unroll
            for (int j = 0; j < 8; ++j) el[j] = le[j] * rs;
            int i1 = 0; float v1 = el[0];
#pragma unroll
            for (int j = 1; j < 8; ++j) if (el[j] > v1) { v1 = el[j]; i1 = j; }
            int i2 = -1; float v2 = -3.0e38f;
#pragma unroll
            for (int j = 0; j < 8; ++j) if (j != i1 && el[j] > v2) { v2 = el[j]; i2 = j; }
            const float ex = __expf(v2 - v1); const float s1 = 1.f / (1.f + ex);
            w0 = pg * s1; w1 = pg * (ex * s1);
            G0 = gi * 8 + i1; G1 = 32 + gi * 8 + i2;
            lr0 = __hip_atomic_fetch_add(&HIST[G0], 1u, __ATOMIC_RELAXED, __HIP_MEMORY_SCOPE_WORKGROUP); lr1 = __hip_atomic_fetch_add(&HIST[G1], 1u, __ATOMIC_RELAXED, __HIP_MEMORY_SCOPE_WORKGROUP);
        }
        __syncthreads();
        if (tid < 64) { const unsigned n = HIST[tid]; BASE[tid] = n ? atomicAdd(&CNT[tid], n) : 0u; }
        __syncthreads();
        if (lane < 16) { const unsigned p0 = BASE[G0] + lr0, p1 = BASE[G1] + lr1;
            TOKL[(size_t)G0 * M + p0] = tok; WL[(size_t)G0 * M + p0] = w0; TOKL[(size_t)G1 * M + p1] = tok; WL[(size_t)G1 * M + p1] = w1; }
        __syncthreads();
    }
}
__device__ __forceinline__ void moe_tables(Ctx& X) {
    const unsigned* CNT = (const unsigned*)(X.ws + WS_CTL) + CW_CNT;
    LAS int* PRE = (LAS int*)(X.lds + LC_PRE); LAS int* CNTL = (LAS int*)(X.lds + LC_CNT);
    const int tid = opaque_tid(X.wave);
    __syncthreads();
    if (tid < 64) CNTL[tid] = (int)__hip_atomic_load(CNT + tid, __ATOMIC_RELAXED, __HIP_MEMORY_SCOPE_AGENT);
    __syncthreads();
    if (tid < 64) { int a = 0;
#pragma unroll 8
        for (int g = 0; g < NGRP; ++g) { const int t = (CNTL[g] + 255) >> 8; a += (g <= tid) ? t : 0; }
        PRE[tid + 1] = a; if (tid == 0) PRE[0] = 0; }
    __syncthreads();
}

__global__ void __launch_bounds__(512, 2) hymba_fwd(Args args) {
    extern __shared__ __attribute__((aligned(16))) unsigned char smem[];
    Ctx X;
    X.lds = (LAS unsigned char*)smem; X.tid = 0; X.lane = 0; X.wave = __builtin_amdgcn_readfirstlane((int)threadIdx.x >> 6);
    X.G = gridDim.x; X.c = blockIdx.x; { const int bx = blockIdx.x; X.vcu = (X.G % 8 == 0) ? (bx % 8) * (X.G / 8) + bx / 8 : bx; }
    X.h = GP(args.out); X.ws = GP(args.ws);
    unsigned char* ws0 = GP(args.ws);
    for (int u = threadIdx.x; u < (LDS_BYTES - LC_BASE) / 4; u += 512) ((LAS unsigned*)(X.lds + LC_BASE))[u] = 0u;
    __syncthreads();
    const int lo = args.ph_lo, hi = args.ph_hi;
    const bool multi = (hi - lo) > 1;
    XcdBarrier bar; bar.bar = (unsigned*)(ws0 + WS_CTL) + CW_BAR; bar.x = 0; bar.st = nullptr;
    if (multi) bar = xcd_barrier_post((unsigned*)(ws0 + WS_CTL) + CW_BAR, (volatile LAS unsigned*)(X.lds + LC_BAR));
#ifndef PH_MASK
#define PH_MASK 0x7ff
#endif
#define PHASE_WS unsigned char* ws = GP(ws0); X.ws = ws; asm volatile("" : "+s"(X.G), "+s"(X.c), "+s"(X.vcu))
#define PHEN(j) (((PH_MASK) >> (j)) & 1)
#define IN(k) (lo <= (k) && (k) < hi)
#define SEAM(k) do { if ((k) + 1 < hi) xcd_barrier(bar, X.wave); } while (0)
    float* ss_mix = (float*)(ws0 + SS_MIX); float* ss_ffn = (float*)(ws0 + SS_FFN);
    float* ss_pg = (float*)(ws0 + SS_PG); float* ss_ple = (float*)(ws0 + SS_PLE);
    bf16* HB = (bf16*)(ws0 + WS_HB);
    const int NGT = X.G * 512;

    if (PHEN(10) && IN(0)) { prologue(X); SEAM(0); }

    for (int l = 0; l < DEPTH; ++l) {
        const int pb = 1 + 10 * l;
        if (PHEN(0) && IN(pb + 0)) { PHASE_WS;
            { int cc = X.c; asm volatile("" : "+s"(cc)); const int gt = cc * 512 + opaque_tid(X.wave);
              if (gt < 64) ((unsigned*)(ws + WS_CTL) + CW_CNT)[gt] = 0u; }
            int cin = X.c; asm volatile("" : "+s"(cin));
            pg8::InSched S; S.soA.init(M, 4 * 256, X.G, cin); S.soB.init(M, IN_W - 4 * 256, X.G, cin); S.split = (X.G == 256); S.A = (const char*)(ws + WS_HB); S.Bt = (const char*)(ws + WS_WIN) + (size_t)l * IN_W * D * 2; S.K = D;
            EpiIn E{ws, l};
            pg8::gemm_phase<EpiIn, pg8::InSched>(X.lds, D, S, E, X.wave);
            SEAM(pb + 0);
        }
        if (PHEN(1) && IN(pb + 1)) { PHASE_WS;
            attn_phase(X, l);
            hgrn_pass<false>(X, l);
            SEAM(pb + 1);
        }
        if (PHEN(2) && IN(pb + 2)) { PHASE_WS; hgrn_scan(X); SEAM(pb + 2); }
        if (PHEN(3) && IN(pb + 3)) { PHASE_WS; hgrn_pass<true>(X, l); SEAM(pb + 3); }
        if (PHEN(4) && IN(pb + 4)) { PHASE_WS;
            pg8::RegSched S; S.so.init(M, D, X.G, X.c); S.A = (const char*)(ws + WS_MIX); S.Bt = (const char*)(ws + WS_WOUT) + (size_t)l * D * D; S.K = D / 2;
            EpiResid E{ws};
            pg8::gemm_phase<EpiResid, pg8::RegSched>(X.lds, D / 2, S, E, X.wave);
            SEAM(pb + 4);
        }
        if (PHEN(5) && IN(pb + 5)) { PHASE_WS;
            router_phase(X, l);
            SEAM(pb + 5);
        }
#pragma unroll 1
        for (int mp = 0; mp < 3; ++mp) {
            if (!(PHEN(6 + mp) && IN(pb + 6 + mp))) continue;
            PHASE_WS;
            moe_tables(X);
            const LAS int* PRE = (const LAS int*)(X.lds + LC_PRE); const LAS int* CNTL = (const LAS int*)(X.lds + LC_CNT);
            const int U6 = 4 * PRE[64], U7 = 4 * PRE[32], U8 = U6 - U7;
            if (mp == 0) {
                pg8::MoeSched<true> S; S.pre = PRE; S.cntl = CNTL; S.ubeg = 0; S.uend = U6; S.G = X.G; S.c = X.vcu; S.tokl = (const int*)(ws + WS_TOKL); S.A = (const char*)(ws + WS_HB2F8);
                S.W = (const char*)(ws + WS_WGU) + (size_t)l * NEXP * 1024 * D; S.K = D / 2; S.wstride = (size_t)1024 * D;
                EpiMoe1 E{ws, CNTL};
                pg8::gemm_phase<EpiMoe1, pg8::MoeSched<true>>(X.lds, D / 2, S, E, X.wave);
            } else {
                pg8::MoeSched<false> S; S.pre = PRE; S.cntl = CNTL; S.ubeg = (mp == 1) ? 0 : U7; S.uend = (mp == 1) ? U7 : U6; S.G = X.G; S.c = X.vcu; S.tokl = (const int*)(ws + WS_TOKL); S.A = (const char*)(ws + WS_HID);
                S.W = (const char*)(ws + WS_WD) + (size_t)l * NEXP * D * FF; S.K = FF / 2; S.wstride = (size_t)D * FF;
                EpiMoe2 E{ws, CNTL, mp == 2};
                pg8::gemm_phase<EpiMoe2, pg8::MoeSched<false>>(X.lds, FF / 2, S, E, X.wave);
            }
            {
                const int NPL = (M / 256) * (D / 256);
                const int r6 = U6 % X.G, r7 = U7 % X.G, r8 = U8 % X.G;
                const int t6 = (X.G - r6) < NPL ? (X.G - r6) : NPL, t7 = (X.G - r7) < (NPL - t6) ? (X.G - r7) : (NPL - t6), t8 = NPL - t6 - t7;
                pg8::TailSched T; T.G = X.G; T.c = X.vcu;
                T.nunits = (mp == 0) ? t6 : (mp == 1) ? t7 : t8; T.ubase = (mp == 0) ? 0 : (mp == 1) ? t6 : t6 + t7; T.nbig = (mp == 0) ? r6 : (mp == 1) ? r7 : r8;
                T.A = (const char*)(ws + WS_PB) + (size_t)l * M * PLE * 2; T.Bt = (const char*)(ws + WS_WPLE) + (size_t)l * D * PLE * 2; T.K = PLE;
                EpiPle1 E1{ws};
                pg8::gemm_phase<EpiPle1, pg8::TailSched>(X.lds, PLE, T, E1, X.wave);
            }
            SEAM(pb + 6 + mp);
        }
        if (PHEN(9) && IN(pb + 9)) { PHASE_WS;
            pg8::RegSched S; S.so.init(M, D, X.G, X.c); S.A = (const char*)(ws + WS_HB2); S.Bt = (const char*)(ws + WS_WPG) + (size_t)l * D * D * 2; S.K = D;
            EpiPle2 E{(l == DEPTH - 1) ? X.h : nullptr, ws, l};
            pg8::gemm_phase<EpiPle2, pg8::RegSched>(X.lds, D, S, E, X.wave);
            SEAM(pb + 9);
        }
    }
    if (multi && hi == 1 + 10 * DEPTH) {
        if (xb_ld((unsigned*)(ws0 + WS_CTL) + CW_BAR + XB_TMO) != 0u && opaque_tid(X.wave) == 0) X.h[(size_t)blockIdx.x * D] = __builtin_nanf("");
    }
#undef PHASE_WS
#undef IN
#undef SEAM
}

extern "C" void kernel_launch(void* const* d_in, const int* in_sizes, int n_in, void* d_out, int out_size, void* d_ws, size_t ws_size, hipStream_t stream) {
    static int grid = 0;
    if (grid == 0) {
        if (n_in != 21 || out_size != M * D || ws_size < WS_END) { fprintf(stderr, "kernel_launch: unexpected problem (n_in %d, out %d, ws %zu < %zu)\n", n_in, out_size, ws_size, (size_t)WS_END); grid = -1; return; }
        int dev = 0, cus = 0, per_cu = 0;
        if (hipGetDevice(&dev) != hipSuccess || hipDeviceGetAttribute(&cus, hipDeviceAttributeMultiprocessorCount, dev) != hipSuccess) { grid = -1; return; }
        if (hipFuncSetAttribute((const void*)hymba_fwd, hipFuncAttributeMaxDynamicSharedMemorySize, LDS_BYTES) != hipSuccess) { fprintf(stderr, "kernel_launch: hipFuncSetAttribute failed\n"); grid = -1; return; }
        if (hipOccupancyMaxActiveBlocksPerMultiprocessor(&per_cu, (const void*)hymba_fwd, 512, LDS_BYTES) != hipSuccess || per_cu < 1) { fprintf(stderr, "kernel_launch: occupancy query says %d\n", per_cu); per_cu = 1; }
        (void)hipGetLastError();
        grid = cus;
    }
    if (grid < 0) return;
    (void)hipMemsetAsync((char*)d_ws + WS_CTL, 0, CTL_ZERO_BYTES, stream);
    Args a{};
    for (int i = 0; i < 21; ++i) a.in[i] = (const float*)d_in[i];
    a.out = (float*)d_out; a.ws = (unsigned char*)d_ws;
#if ONE_LAUNCH
    a.ph_lo = 0; a.ph_hi = PH_HI;
    hipLaunchKernelGGL(hymba_fwd, dim3(grid), dim3(512), LDS_BYTES, stream, a);
#else
    for (int p = 0; p < PH_HI; ++p) { a.ph_lo = p; a.ph_hi = p + 1; hipLaunchKernelGGL(hymba_fwd, dim3(grid), dim3(512), LDS_BYTES, stream, a); }
#endif
}
```

```cpp
#include <hip/hip_runtime.h>
#include <cstdio>
#include <cstdint>

#ifndef ONE_LAUNCH
#define ONE_LAUNCH 1
#endif
#ifndef PH_HI
#define PH_HI 41

#endif

#define LAS __attribute__((address_space(3)))
typedef unsigned short bf16;
typedef short bf16x8 __attribute__((ext_vector_type(8)));
typedef short s16x4 __attribute__((ext_vector_type(4)));
typedef float f32x4 __attribute__((ext_vector_type(4)));
typedef float f32x16 __attribute__((ext_vector_type(16)));
typedef unsigned u32x4 __attribute__((ext_vector_type(4)));
typedef unsigned u32x2 __attribute__((ext_vector_type(2)));
typedef int v8i __attribute__((ext_vector_type(8)));
typedef short s16x16 __attribute__((ext_vector_type(16)));

constexpr int D = 1024, BATCH = 4, SEQ = 8192, DEPTH = 4, M = BATCH * SEQ;
constexpr int IN_W = 2816;
constexpr int NEXP = 32, FF = 512, PLE = 256;
constexpr int NGRP = 64;
constexpr float EPS = 1e-6f;

constexpr size_t MiB = 1u << 20;
constexpr size_t WS_CTL = 0, CTL_ZERO_BYTES = 1 * MiB;
constexpr float HID_SCALE = 4.f, WD_SCALE = 32.f;
constexpr float MIX_SCALE = 4.f, WOUT_SCALE = 32.f;
constexpr size_t WS_WIN = 1 * MiB, WS_WOUT = 23 * MiB, WS_WPLE = 31 * MiB, WS_WPG = 33 * MiB, WS_WR = 41 * MiB, WS_MISC = 42 * MiB;
constexpr size_t WS_WGU = 48 * MiB, WS_WD = 304 * MiB, WS_HB = 432 * MiB, WS_Q = 496 * MiB, WS_K = 528 * MiB, WS_V = 536 * MiB;
constexpr size_t WS_QR = 544 * MiB, WS_KEY = 576 * MiB, WS_IR = 608 * MiB, WS_GR = 640 * MiB, WS_LF = 672 * MiB, WS_MIX = 736 * MiB;
constexpr size_t WS_USUP = 800 * MiB, WS_PB = 832 * MiB, WS_TOKL = 896 * MiB, WS_WL = 904 * MiB, WS_HB2 = 912 * MiB, WS_SS = 976 * MiB, WS_CHS = 984 * MiB, WS_RSL = 988 * MiB  , WS_END = 996 * MiB;
constexpr size_t WS_HB2F8 = 176 * MiB;
constexpr size_t WS_HID = WS_QR;
constexpr size_t WS_PLERAW = WS_LF;
constexpr size_t SS_MIX = WS_SS, SS_FFN = WS_SS + 2 * MiB, SS_PG = WS_SS + 4 * MiB, SS_PLE = WS_SS + 6 * MiB;
constexpr size_t MISC_COS = 1 * MiB, MISC_SIN = 2 * MiB, MISC_LB = 3 * MiB, MISC_DSUP = 4 * MiB;
constexpr int CW_TMO = 0, CW_CNT = 1024, CW_BAR = 4096;

constexpr int STAGE_BYTES = 131072;
constexpr int LC_BASE = 133120;
constexpr int LC_PRE = LC_BASE, LC_CNT = LC_BASE + 320, LC_BAR = LC_BASE + 576;
constexpr int LDS_BYTES = LC_BASE + 2048;

__device__ __forceinline__ unsigned f2bf(float f) { unsigned u = __builtin_bit_cast(unsigned, f); return (u + 0x7fffu + ((u >> 16) & 1u)) >> 16; }
__device__ __forceinline__ unsigned pk2(float lo, float hi) { return f2bf(lo) | (f2bf(hi) << 16); }
__device__ __forceinline__ float bf2f(unsigned b) { return __builtin_bit_cast(float, b << 16); }
__device__ __forceinline__ unsigned cvt_pk_bf16(float lo, float hi) { unsigned r; asm volatile("v_cvt_pk_bf16_f32 %0, %1, %2" : "=v"(r) : "v"(lo), "v"(hi)); return r; }
__device__ __forceinline__ float fast_exp(float x) { return __builtin_amdgcn_exp2f(x * 1.4426950408889634f); }
__device__ __forceinline__ float silu(float x) { const float t = fast_exp(-x); return x * __builtin_amdgcn_rcpf(1.f + t); }
__device__ __forceinline__ float clamp_f8(float x) { float y; asm("v_max_f32 %0, 0xc3e00000, %1\n\tv_min_f32 %0, 0x43e00000, %0" : "=&v"(y) : "v"(x)); return y; }
__device__ __forceinline__ u32x2 pk_fp8x8(const f32x4& a, const f32x4& b) {
    int lo = __builtin_amdgcn_cvt_pk_fp8_f32(a[0], a[1], 0, false); lo = __builtin_amdgcn_cvt_pk_fp8_f32(a[2], a[3], lo, true);
    int hi = __builtin_amdgcn_cvt_pk_fp8_f32(b[0], b[1], 0, false); hi = __builtin_amdgcn_cvt_pk_fp8_f32(b[2], b[3], hi, true);
    u32x2 r; r.x = (unsigned)lo; r.y = (unsigned)hi; return r;
}
typedef _Float16 h16x2 __attribute__((ext_vector_type(2)));
#define MFMA16(a, b, c) __builtin_amdgcn_mfma_f32_16x16x32_bf16((a), (b), (c), 0, 0, 0)
#define MFMA32(a, b, c) __builtin_amdgcn_mfma_f32_32x32x16_bf16((a), (b), (c), 0, 0, 0)

#define GAS1 __attribute__((address_space(1)))
template <class T> __device__ __forceinline__ T* GP(T* p) { GAS1 T* g = (GAS1 T*)p; asm volatile("" : "+s"(g)); return (T*)g; }
__device__ __forceinline__ int lane_here() { int l; asm volatile("v_mbcnt_lo_u32_b32 %0, -1, 0\n\tv_mbcnt_hi_u32_b32 %0, -1, %0" : "=v"(l)); return l; }
__device__ __forceinline__ float shx(float v, int m) { return __builtin_bit_cast(float, __builtin_amdgcn_ds_bpermute((lane_here() ^ m) << 2, __builtin_bit_cast(int, v))); }
__device__ __forceinline__ float shl15(float v) { return __builtin_bit_cast(float, __builtin_amdgcn_ds_bpermute((lane_here() | 15) << 2, __builtin_bit_cast(int, v))); }
__device__ __forceinline__ const float* inp(int k) {
    unsigned long long kp = (unsigned long long)__builtin_amdgcn_kernarg_segment_ptr(); asm volatile("" : "+s"(kp));
    return (const float*)(GAS1 const float*)((const unsigned long long __attribute__((address_space(4)))*)kp)[k];
}

__device__ __forceinline__ int opaque_tid(int wave) {
    return wave * 64 + lane_here(); }

#define XB_TMO      128
#define XB_XCNT(j)  (256  + 64 * (j))
#define XB_XSUB(j)  (1280 + 64 * (j))
#define XB_XGEN(j)  (2304 + 64 * (j))
#define XB_TOP      3328
#define XB_TOPGEN   3392
#define XCD_BAR_WORDS 3456
#define XB_SPIN_CAP (1u << 18)
__device__ __forceinline__ unsigned xb_ld(unsigned* p)              { return __hip_atomic_load(p, __ATOMIC_RELAXED, __HIP_MEMORY_SCOPE_AGENT); }
__device__ __forceinline__ unsigned xb_add(unsigned* p, unsigned v) { return __hip_atomic_fetch_add(p, v, __ATOMIC_RELAXED, __HIP_MEMORY_SCOPE_AGENT); }
__device__ __forceinline__ unsigned xb_xcc_id() { return (unsigned)__builtin_amdgcn_s_getreg((3 << 11) | 20) & 0xFu; }
#define XB_SPIN(cond, bar) do { unsigned _sp = 0; while (cond) { __builtin_amdgcn_s_sleep(1); \
    if ((++_sp & 255u) == 0u) { if (xb_ld(&(bar)[XB_TMO])) break; if (_sp > XB_SPIN_CAP) { atomicAdd(&(bar)[XB_TMO], 1u); break; } } } } while (0)
struct XcdBarrier { unsigned* bar; unsigned x; volatile LAS unsigned* st; };
__device__ __forceinline__ XcdBarrier xcd_barrier_post(unsigned* bar, volatile LAS unsigned* st) {
    XcdBarrier b; b.bar = bar; b.x = xb_xcc_id(); b.st = st;
    if (threadIdx.x == 0) (void)xb_add(&bar[XB_XCNT(b.x)], 1u);
    return b;
}
__device__ __forceinline__ void xcd_barrier_complete(unsigned* bar, unsigned x, unsigned& nloc, unsigned& nx) {
    const unsigned G = gridDim.x * gridDim.y * gridDim.z;
    unsigned sum, cnt, mine, sp = 0u;
    for (;;) {
        sum = 0u; cnt = 0u; mine = 0u;
#pragma unroll
        for (unsigned j = 0; j < 16; ++j) { const unsigned c = xb_ld(&bar[XB_XCNT(j)]); sum += c; cnt += (c > 0u) ? 1u : 0u; mine = (j == x) ? c : mine; }
        if (sum == G) break;
        __builtin_amdgcn_s_sleep(1);
        if ((++sp & 255u) == 0u) { if (xb_ld(&bar[XB_TMO])) break; if (sp > XB_SPIN_CAP) { atomicAdd(&bar[XB_TMO], 1u); break; } }
    }
    nloc = mine > 0u ? mine : 1u; nx = cnt > 0u ? cnt : 1u;
}
__device__ __forceinline__ void xcd_barrier(const XcdBarrier& b, const int wave) {
    asm volatile("s_waitcnt vmcnt(0)" ::: "memory");
    __syncthreads();
    if (wave == 0 && lane_here() == 0) {
        unsigned* bar = GP(b.bar);
        __builtin_amdgcn_s_waitcnt(0);
        unsigned nloc = b.st[0], nx = b.st[1];
        if (nloc == 0u) { xcd_barrier_complete(bar, b.x, nloc, nx); b.st[0] = nloc; b.st[1] = nx; }
        const unsigned old = xb_add(&bar[XB_XSUB(b.x)], 1u);
        const unsigned gen = old / nloc;
        if (old + 1u == (gen + 1u) * nloc) {
            __builtin_amdgcn_fence(__ATOMIC_RELEASE, "agent");
            asm volatile("s_waitcnt vmcnt(0)" ::: "memory");
            const unsigned og = xb_add(&bar[XB_TOP], 1u);
            const unsigned tg = og / nx;
            if (og + 1u == (tg + 1u) * nx) xb_add(&bar[XB_TOPGEN], 1u);
            else XB_SPIN(xb_ld(&bar[XB_TOPGEN]) == tg, bar);
            __builtin_amdgcn_fence(__ATOMIC_ACQUIRE, "agent");
            xb_add(&bar[XB_XGEN(b.x)], 1u);
            asm volatile("s_waitcnt vmcnt(0)" ::: "memory");
        } else {
            XB_SPIN(xb_ld(&bar[XB_XGEN(b.x)]) == gen, bar);
            __builtin_amdgcn_fence(__ATOMIC_ACQUIRE, "agent");
            asm volatile("s_waitcnt vmcnt(0)" ::: "memory");
        }
    }
    __syncthreads();
}

namespace pg8 {
constexpr int BM = 256, BK = 64, HALF = 128, HTB = HALF * BK * 2, NXCD = 8, WGM = 8;
__device__ __forceinline__ int lds_byte(int r, int c) { const int st = (r >> 4) * 2 + (c >> 5), rr = r & 15, cc = c & 31, ob = rr * 64 + cc * 2; return st * 1024 + (ob ^ (((ob >> 9) & 1) << 5)); }
__device__ __forceinline__ void stage_rc(int b, int& R, int& C) { const int st = b / 1024, sb = b % 1024, swz = sb ^ (((sb >> 9) & 1) << 5); R = (st >> 1) * 16 + swz / 64; C = (st & 1) * 32 + (swz % 64) / 2; }
__device__ __forceinline__ int perm32(int rho) { const int n = rho >> 4, i = rho & 15; return 8 * (i >> 2) + 4 * n + (i & 3); }
struct Unit { int pm, pn, g, mt; };

struct StaticOrder {
    int nM, nN, nwg, G, c;
    __device__ void init(int M_, int N_, int G_, int c_) { nM = M_ / BM; nN = N_ / BM; nwg = nM * nN; G = G_; c = c_; }
    __device__ bool next(int i, Unit& u) const { return at((long)i * G + c, u); }
    __device__ bool at(long L, Unit& u) const {
        if (L >= nwg) return false;
        int wgid = (int)L; { const int q = nwg / NXCD, r = nwg % NXCD, xcd = wgid % NXCD, off = wgid / NXCD; wgid = (xcd < r ? xcd * (q + 1) : r * (q + 1) + (xcd - r) * q) + off; }
        const int nig = WGM * nN, gid = wgid / nig, fm = gid * WGM, gsz = (nM - fm) < WGM ? (nM - fm) : WGM;
        u.pm = fm + ((wgid % nig) % gsz); u.pn = (wgid % nig) / gsz; u.g = 0; u.mt = 0; return true;
    }
};
struct RegSched {
    static constexpr bool LANE_PER_UNIT = false;
    StaticOrder so; const char* A; const char* Bt; int K;
    __device__ __forceinline__ bool next(int i, Unit& u) const { return so.next(i, u); }
    __device__ __forceinline__ const char* a_ubase(const Unit& u) const { return A + (size_t)u.pm * BM * K * 2; }
    __device__ __forceinline__ size_t hstepA() const { return (size_t)HALF * K * 2; }
    __device__ __forceinline__ unsigned a_lane(const Unit&, int, int R, unsigned c2) const { return (unsigned)(R * K * 2) + c2; }
    __device__ __forceinline__ const char* b_base(const Unit& u) const { return Bt + (size_t)u.pn * BM * K * 2; }
};
struct InSched {
    static constexpr bool LANE_PER_UNIT = false;
    StaticOrder soA, soB; const char* A; const char* Bt; int K; bool split;
    __device__ __forceinline__ bool next(int i, Unit& u) const {
        bool ok;
        if (split) {
            const int c = soA.c, h = c >> 7, cl = c & 127, nA = h ? 3 : 1;
            if (i < nA) { ok = soA.at(h ? (long)i * 128 + cl : 384 + cl, u); u.pn = 3 + 2 * u.pn; return ok; }
            const int j = i - nA; if (j >= (h ? 2 : 5)) return false;
            ok = soB.at(h ? 640 + (long)j * 128 + cl : (long)j * 128 + cl, u);
        } else {
            if (i < 2) { ok = soA.next(i, u); u.pn = 3 + 2 * u.pn; return ok; }
            ok = soB.next(i - 2, u);
        }
        u.pn = (u.pn < 3) ? u.pn : 2 * u.pn - 2; return ok;
    }
    __device__ __forceinline__ const char* a_ubase(const Unit& u) const { return A + (size_t)u.pm * BM * K * 2; }
    __device__ __forceinline__ size_t hstepA() const { return (size_t)HALF * K * 2; }
    __device__ __forceinline__ unsigned a_lane(const Unit&, int, int R, unsigned c2) const { return (unsigned)(R * K * 2) + c2; }
    __device__ __forceinline__ const char* b_base(const Unit& u) const { return Bt + (size_t)u.pn * BM * K * 2; }
};
struct TailSched {
    static constexpr bool LANE_PER_UNIT = false;
    int nunits, nbig, G, c, ubase; const char* A; const char* Bt; int K;
    __device__ __forceinline__ bool next(int i, Unit& u) const {
        const int nt = G - nbig, ct = c - nbig; if (ct < 0) return false;
        int U = i * nt + ct; if (U >= nunits) return false;
        U += ubase; u.pm = U >> 2; u.pn = U & 3; u.g = 0; u.mt = 0; return true;
    }
    __device__ __forceinline__ const char* a_ubase(const Unit& u) const { return A + (size_t)u.pm * BM * K * 2; }
    __device__ __forceinline__ size_t hstepA() const { return (size_t)HALF * K * 2; }
    __device__ __forceinline__ unsigned a_lane(const Unit&, int, int R, unsigned c2) const { return (unsigned)(R * K * 2) + c2; }
    __device__ __forceinline__ const char* b_base(const Unit& u) const { return Bt + (size_t)u.pn * BM * K * 2; }
};
template <bool GATHER> struct MoeSched {
    static constexpr bool LANE_PER_UNIT = GATHER;

    const LAS int* pre; const LAS int* cntl; int ubeg, uend, G, c;
    const int* tokl; const char* A; const char* W; int K; size_t wstride;
    __device__ __forceinline__ bool next(int i, Unit& u) const {
        const int U = ubeg + i * G + c; if (U >= uend) return false;
        const int mg = U >> 2; const int lane = lane_here();
        const unsigned long long bal = __ballot(pre[lane] <= mg);
        const int g = __popcll(bal) - 1;
        u.pm = mg; u.pn = U & 3; u.g = g; u.mt = mg - pre[g]; return true;
    }
    __device__ __forceinline__ const char* a_ubase(const Unit& u) const { return GATHER ? A : A + (size_t)u.pm * BM * K * 2; }
    __device__ __forceinline__ size_t hstepA() const { return GATHER ? (size_t)0 : (size_t)HALF * K * 2; }
    __device__ __forceinline__ unsigned a_lane(const Unit& u, int h, int R, unsigned c2) const {
        if (GATHER) { const int cg = cntl[u.g]; const int rg = u.mt * BM + h * HALF + R; const int tok = tokl[(size_t)u.g * M + (rg < cg ? rg : 0)]; return (unsigned)tok * (unsigned)(K * 2) + c2; }
        return (unsigned)(R * K * 2) + c2;
    }
    __device__ __forceinline__ const char* b_base(const Unit& u) const { return W + (size_t)(u.g & 31) * wstride + (size_t)u.pn * BM * K * 2; }
};

template <class Epi, class Sched>
__device__ __forceinline__ void gemm_phase(LAS unsigned char* lds, const int Kc, const Sched& S, const Epi& E, const int wave0) {
    int K = Kc; asm volatile("" : "+s"(K));
    const int tid = opaque_tid(wave0), wid = __builtin_amdgcn_readfirstlane(tid >> 6), lane = tid & 63, wr = wid >> 2, wc = wid & 3, fr = lane & 15, fq = lane >> 4;
    const int nt = K / BK;
    unsigned voffB[2];
#pragma unroll
    for (int i = 0; i < 2; ++i) { int R, C; stage_rc(tid * 16 + i * 8192, R, C); const int Rb = Epi::PERM ? ((R & ~31) + perm32(R & 31)) : R;
        voffB[i] = (unsigned)(Rb * K + C) * 2u; }
#define PG8_ALANE(dst, unit) do { const int _t = opaque_tid(wave0); _Pragma("unroll") for (int _i = 0; _i < 2; ++_i) { int _R, _C; stage_rc(_t * 16 + _i * 8192, _R, _C); \
        _Pragma("unroll") for (int _h = 0; _h < 2; ++_h) dst[_h][_i] = S.a_lane(unit, _h, _R, (unsigned)_C * 2u); } } while (0)
    const size_t kstep = (size_t)(BK * 2);
    const size_t hstepB = (size_t)HALF * K * 2;
    const unsigned ldsw = (unsigned)wid * 1024u;
    const int aoff = lds_byte(wr * 64 + fr, fq * 8), boff = lds_byte(wc * 32 + fr, fq * 8);
#define PG8_SA(b, h) (((b) * 2 + (h)) * HTB)
#define PG8_SB(b, h) ((4 + (b) * 2 + (h)) * HTB)
#define PG8_STAGE_B(bufoff, gbase) do { _Pragma("unroll") for (int _i = 0; _i < 2; ++_i) { unsigned _o = voffB[_i]; asm volatile("" : "+v"(_o)); \
        __builtin_amdgcn_global_load_lds((const unsigned*)((const char*)(gbase) + _o), (LAS unsigned*)(lds + (bufoff) + ldsw + _i * 8192), 16, 0, 0); } } while (0)
#define PG8_STAGE_A(bufoff, gbase, offs) do { _Pragma("unroll") for (int _i = 0; _i < 2; ++_i) { unsigned _o = (offs)[_i]; asm volatile("" : "+v"(_o)); \
        __builtin_amdgcn_global_load_lds((const unsigned*)((const char*)(gbase) + _o), (LAS unsigned*)(lds + (bufoff) + ldsw + _i * 8192), 16, 0, 0); } } while (0)
#define PG8_LDA(dst, b, h) do { _Pragma("unroll") for (int m = 0; m < 4; ++m) { const bf16x8 _l = *(const LAS bf16x8*)(lds + PG8_SA(b, h) + aoff + m * 2048), _h = *(const LAS bf16x8*)(lds + PG8_SA(b, h) + aoff + m * 2048 + 1024); \
        dst[m] = __builtin_shufflevector(_l, _h, 0, 1, 2, 3, 4, 5, 6, 7, 8, 9, 10, 11, 12, 13, 14, 15); } } while (0)
#define PG8_LDB(dst, b, h) do { _Pragma("unroll") for (int n = 0; n < 2; ++n) { const bf16x8 _l = *(const LAS bf16x8*)(lds + PG8_SB(b, h) + boff + n * 2048), _h = *(const LAS bf16x8*)(lds + PG8_SB(b, h) + boff + n * 2048 + 1024); \
        dst[n] = __builtin_shufflevector(_l, _h, 0, 1, 2, 3, 4, 5, 6, 7, 8, 9, 10, 11, 12, 13, 14, 15); } } while (0)
#define PG8_LO(v) __builtin_shufflevector(v, v, 0, 1, 2, 3, 4, 5, 6, 7)
#define PG8_HI(v) __builtin_shufflevector(v, v, 8, 9, 10, 11, 12, 13, 14, 15)
#define PG8_MMA(ai, bj, At, Bt) do { __builtin_amdgcn_s_setprio(1); _Pragma("unroll") for (int m = 0; m < 4; ++m) _Pragma("unroll") for (int n = 0; n < 2; ++n) { \
        acc[ai][bj][m][n] = __builtin_amdgcn_mfma_f32_16x16x32_bf16(PG8_LO(Bt[n]), PG8_LO(At[m]), acc[ai][bj][m][n], 0, 0, 0); \
        acc[ai][bj][m][n] = __builtin_amdgcn_mfma_f32_16x16x32_bf16(PG8_HI(Bt[n]), PG8_HI(At[m]), acc[ai][bj][m][n], 0, 0, 0); } __builtin_amdgcn_s_setprio(0); } while (0)
#define PG8_MMA8(ai, bj, At, Bt) do { __builtin_amdgcn_s_setprio(1); _Pragma("unroll") for (int m = 0; m < 4; ++m) _Pragma("unroll") for (int n = 0; n < 2; ++n) { \
        acc[ai][bj][m][n] = __builtin_amdgcn_mfma_scale_f32_16x16x128_f8f6f4(__builtin_bit_cast(v8i, Bt[n]), __builtin_bit_cast(v8i, At[m]), acc[ai][bj][m][n], 0, 0, 0, 0x7f7f7f7f, 0, 0x7f7f7f7f); } __builtin_amdgcn_s_setprio(0); } while (0)
#define PG8_MM(ai, bj, At, Bt) do { if constexpr (Epi::F8) PG8_MMA8(ai, bj, At, Bt); else PG8_MMA(ai, bj, At, Bt); } while (0)
#define PG8_WAIT_V(n) asm volatile("s_waitcnt vmcnt(" #n ")" ::: "memory")
#define PG8_WAIT_V8_UNLESS(f) asm volatile("s_cmp_lg_u32 %0, 0\n\ts_cbranch_scc1 1f\n\ts_waitcnt vmcnt(8)\n1:" :: "s"(f) : "memory", "scc")
#define PG8_WAIT_L(n) asm volatile("s_waitcnt lgkmcnt(" #n ")" ::: "memory")
#define PG8_BAR __builtin_amdgcn_s_barrier()
#define PG8_SCHED __builtin_amdgcn_sched_barrier(0)
    Unit cur, nxt; int ui = 0;
    if (!S.next(0, cur)) return;
    const size_t hstepA = S.hstepA();
    unsigned coff[2][2], noff[2][2];
    PG8_ALANE(coff, cur);
    const char* cA = S.a_ubase(cur);
    const char* cB = S.b_base(cur);
    f32x4 acc[2][2][4][2];
#pragma unroll
    for (int a = 0; a < 2; ++a)
#pragma unroll
        for (int b = 0; b < 2; ++b)
#pragma unroll
            for (int m = 0; m < 4; ++m)
#pragma unroll
                for (int n = 0; n < 2; ++n) acc[a][b][m][n] = (f32x4){0.f, 0.f, 0.f, 0.f};
    s16x16 At[4], B0[2], B1[2];
    PG8_STAGE_B(PG8_SB(0, 0), cB); PG8_STAGE_B(PG8_SB(0, 1), cB + hstepB); PG8_STAGE_A(PG8_SA(0, 0), cA, coff[0]); PG8_STAGE_A(PG8_SA(0, 1), cA + hstepA, coff[1]);
    if (wr == 1) PG8_BAR;
    PG8_WAIT_V(2); PG8_BAR;
    PG8_STAGE_B(PG8_SB(1, 0), cB + kstep); PG8_STAGE_A(PG8_SA(1, 0), cA + kstep, coff[0]); PG8_STAGE_B(PG8_SB(1, 1), cB + hstepB + kstep);
    PG8_WAIT_V(6); PG8_BAR;
    int fast1 = 0;
    for (;;) {
        const bool has_next = S.next(ui + 1, nxt);
        const char* nB = cB; const char* nA = cA;
        if (has_next) {
            if constexpr (Sched::LANE_PER_UNIT) PG8_ALANE(noff, nxt);
            nB = S.b_base(nxt); nA = S.a_ubase(nxt);
        } else if constexpr (Sched::LANE_PER_UNIT) {
#pragma unroll
            for (int h = 0; h < 2; ++h)
#pragma unroll
                for (int i = 0; i < 2; ++i) noff[h][i] = coff[h][i];
        }
        int fz = fast1;
        for (int t = 0; t < nt; t += 2) {
            const bool last = (t == nt - 2); const int f1 = fz; fz = 0; asm volatile("" : "+s"(fz));
            const char* a1 = cA + (size_t)(t + 1) * kstep;
            const char* a2 = last ? nA : cA + (size_t)(t + 2) * kstep;
            const char* b2 = last ? nB : cB + (size_t)(t + 2) * kstep;
            const char* a3 = a2 + kstep; const char* b3 = b2 + kstep;
            PG8_LDB(B0, 0, 0); PG8_LDB(B1, 0, 1); PG8_SCHED; PG8_LDA(At, 0, 0); PG8_STAGE_A(PG8_SA(1, 1), a1 + hstepA, coff[1]);
            PG8_WAIT_V8_UNLESS(f1); PG8_WAIT_L(0); PG8_BAR; PG8_MM(0, 0, At, B0); PG8_MM(0, 1, At, B1); PG8_BAR; PG8_SCHED;
            if (Sched::LANE_PER_UNIT && last) {
#pragma unroll
                for (int h = 0; h < 2; ++h)
#pragma unroll
                    for (int i = 0; i < 2; ++i) coff[h][i] = noff[h][i];
            }
            PG8_LDA(At, 0, 1); PG8_STAGE_B(PG8_SB(0, 0), b2); PG8_STAGE_B(PG8_SB(0, 1), b2 + hstepB); PG8_STAGE_A(PG8_SA(0, 0), a2, coff[0]);
            PG8_WAIT_V8_UNLESS(f1); PG8_WAIT_L(0); PG8_BAR; PG8_MM(1, 0, At, B0); PG8_MM(1, 1, At, B1); PG8_BAR; PG8_SCHED;
            PG8_LDB(B0, 1, 0); PG8_LDB(B1, 1, 1); PG8_SCHED; PG8_LDA(At, 1, 0); PG8_STAGE_A(PG8_SA(0, 1), a2 + hstepA, coff[1]);
            PG8_WAIT_V8_UNLESS(f1); PG8_WAIT_L(0); PG8_BAR; PG8_MM(0, 0, At, B0); PG8_MM(0, 1, At, B1); PG8_BAR; PG8_SCHED;
            PG8_LDA(At, 1, 1); PG8_STAGE_B(PG8_SB(1, 0), b3); PG8_STAGE_B(PG8_SB(1, 1), b3 + hstepB); PG8_STAGE_A(PG8_SA(1, 0), a3, coff[0]);
            PG8_WAIT_V(8); PG8_WAIT_L(0); PG8_BAR; PG8_MM(1, 0, At, B0); PG8_MM(1, 1, At, B1); PG8_BAR; PG8_SCHED;
        }
        if (wr == 0) PG8_BAR;
        if (has_next) PG8_STAGE_A(PG8_SA(1, 1), nA + kstep + hstepA, coff[1]);
#ifdef STUB_EPI
        if (cur.pm == 12345) E(acc, cur, wr, wc, fr, fq); else { float q = 0.f; _Pragma("unroll") for (int a = 0; a < 2; ++a) _Pragma("unroll") for (int b = 0; b < 2; ++b) _Pragma("unroll") for (int m = 0; m < 4; ++m) _Pragma("unroll") for (int n = 0; n < 2; ++n) q += acc[a][b][m][n][0] + acc[a][b][m][n][1] + acc[a][b][m][n][2] + acc[a][b][m][n][3]; if (q == 1.2345f) ((float*)lds)[0] = q; }
#else
        { const int le = lane_here(); E(acc, cur, wr, wc, le & 15, le >> 4); }
#endif
        if (!has_next) break;
#pragma unroll
        for (int a = 0; a < 2; ++a)
#pragma unroll
            for (int b = 0; b < 2; ++b)
#pragma unroll
                for (int m = 0; m < 4; ++m)
#pragma unroll
                    for (int n = 0; n < 2; ++n) acc[a][b][m][n] = (f32x4){0.f, 0.f, 0.f, 0.f};
        cur = nxt; cB = nB; cA = nA; ++ui; fast1 = 1;
        if (wr == 1) PG8_BAR;
    }
    PG8_WAIT_V(0);
    PG8_BAR;
#undef PG8_ALANE
#undef PG8_SA
#undef PG8_SB
#undef PG8_STAGE_A
#undef PG8_STAGE_B
#undef PG8_LDA
#undef PG8_LDB
#undef PG8_LO
#undef PG8_HI
#undef PG8_MMA
#undef PG8_MMA8
#undef PG8_MM
#undef PG8_WAIT_V
#undef PG8_WAIT_L
#undef PG8_WAIT_V8_UNLESS
#undef PG8_BAR
#undef PG8_SCHED
}
}
using pg8::Unit;

__device__ __forceinline__ void up_bf16x8(const u32x4& w, f32x4& a, f32x4& b) {
    a = (f32x4){__builtin_bit_cast(float, w.x << 16), __builtin_bit_cast(float, w.x & 0xffff0000u), __builtin_bit_cast(float, w.y << 16), __builtin_bit_cast(float, w.y & 0xffff0000u)};
    b = (f32x4){__builtin_bit_cast(float, w.z << 16), __builtin_bit_cast(float, w.z & 0xffff0000u), __builtin_bit_cast(float, w.w << 16), __builtin_bit_cast(float, w.w & 0xffff0000u)};
}
__device__ __forceinline__ void ld_bf16x8(const bf16* p, f32x4& a, f32x4& b) {
    const u32x4 w = *(const u32x4*)p;
    a = (f32x4){__builtin_bit_cast(float, w.x << 16), __builtin_bit_cast(float, w.x & 0xffff0000u), __builtin_bit_cast(float, w.y << 16), __builtin_bit_cast(float, w.y & 0xffff0000u)};
    b = (f32x4){__builtin_bit_cast(float, w.z << 16), __builtin_bit_cast(float, w.z & 0xffff0000u), __builtin_bit_cast(float, w.w << 16), __builtin_bit_cast(float, w.w & 0xffff0000u)};
}
__device__ __forceinline__ void st_bf16x8(bf16* p, const f32x4& a, const f32x4& b) {
    u32x4 w; w.x = cvt_pk_bf16(a[0], a[1]); w.y = cvt_pk_bf16(a[2], a[3]); w.z = cvt_pk_bf16(b[0], b[1]); w.w = cvt_pk_bf16(b[2], b[3]);
    *(u32x4*)p = w;
}
__device__ __forceinline__ void st_bf16x4(bf16* p, const f32x4& a) { u32x2 w; w.x = cvt_pk_bf16(a[0], a[1]); w.y = cvt_pk_bf16(a[2], a[3]); *(u32x2*)p = w; }
__device__ __forceinline__ float sq8(const f32x4& a, const f32x4& b) { const f32x4 qa = a * a, qb = b * b; return ((qa[0] + qa[1]) + (qa[2] + qa[3])) + ((qb[0] + qb[1]) + (qb[2] + qb[3])); }
__device__ __forceinline__ float ss_row(const float* ss, int row) {
    const f32x4* p = (const f32x4*)(ss + (size_t)row * 16); const f32x4 a = p[0], b = p[1], c = p[2], d = p[3];
    return (((a[0] + a[1]) + (a[2] + a[3])) + ((b[0] + b[1]) + (b[2] + b[3]))) + (((c[0] + c[1]) + (c[2] + c[3])) + ((d[0] + d[1]) + (d[2] + d[3])));
}
__device__ __forceinline__ float ss_row4(const float* ss, int row, int fq) {
    const f32x4 a = *(const f32x4*)(ss + (size_t)row * 16 + 4 * fq); float s = (a[0] + a[1]) + (a[2] + a[3]);
    s += shx(s, 16); s += shx(s, 32); return s;
}
template <class T> __device__ __forceinline__ T ldo(const void* base, unsigned off) { return *(const T*)((const char*)base + off); }
template <class T> __device__ __forceinline__ void sto(void* base, unsigned off, const T& v) { *(T*)((char*)base + off) = v; }
__device__ __forceinline__ void sto_bf16x8(void* base, unsigned off, const f32x4& a, const f32x4& b) {
    u32x4 w; w.x = cvt_pk_bf16(a[0], a[1]); w.y = cvt_pk_bf16(a[2], a[3]); w.z = cvt_pk_bf16(b[0], b[1]); w.w = cvt_pk_bf16(b[2], b[3]); sto<u32x4>(base, off, w);
}
#define PIN1(x) asm volatile("" : "+v"(x))
#define PIN4(x) asm volatile("" : "+v"(x))
#define EPI_LOADS_DONE() do { asm volatile("s_waitcnt vmcnt(0)" ::: "memory"); __builtin_amdgcn_sched_barrier(0); } while (0)
#define EPI_FENCE() do { asm volatile("" ::: "memory"); __builtin_amdgcn_sched_barrier(0); } while (0)
__device__ __forceinline__ void rs_rows8(const float* ss, int rowb, int fq, float (&rs)[2][4], float post = 1.f) {
    const unsigned ob = (unsigned)rowb * 64u + 16u * (unsigned)fq; f32x4 a[2][4]; const int lh = lane_here(), x16 = (lh ^ 16) << 2, x32 = (lh ^ 32) << 2;
#pragma unroll
    for (int ai = 0; ai < 2; ++ai)
#pragma unroll
        for (int m = 0; m < 4; ++m) a[ai][m] = ldo<f32x4>(ss, ob + (unsigned)(ai * 128 + m * 16) * 64u);
#pragma unroll
    for (int ai = 0; ai < 2; ++ai)
#pragma unroll
        for (int m = 0; m < 4; ++m) { float q = (a[ai][m][0] + a[ai][m][1]) + (a[ai][m][2] + a[ai][m][3]);
            q += __builtin_bit_cast(float, __builtin_amdgcn_ds_bpermute(x16, __builtin_bit_cast(int, q))); q += __builtin_bit_cast(float, __builtin_amdgcn_ds_bpermute(x32, __builtin_bit_cast(int, q)));
            rs[ai][m] = rsqrtf(q + EPS * D) * (32.f * post); PIN1(rs[ai][m]); }
}
#define SS_STORE8(base, rowb_, slot_, v8) do { _Pragma("unroll") for (int _h = 0; _h < 2; ++_h) { const float _v = (fq == 0) ? (v8)[_h][0] : (fq == 1) ? (v8)[_h][1] : (fq == 2) ? (v8)[_h][2] : (v8)[_h][3]; \
        sto<float>((base), (((unsigned)(rowb_) + (unsigned)(_h * 128) + 16u * (unsigned)fq) * 16u + (unsigned)(slot_)) * 4u, _v); } } while (0)
#define ROWS8 _Pragma("unroll") for (int ai = 0; ai < 2; ++ai) _Pragma("unroll") for (int m = 0; m < 4; ++m)
#define RO(ai, m) ((unsigned)((ai) * 128 + (m) * 16))

struct EpiIn {
    static constexpr bool PERM = true, F8 = false;
    unsigned char* ws0; int l;
    __device__ __forceinline__ void operator()(f32x4 (&acc)[2][2][4][2], const Unit& u, int wr, int wc, int fr, int fq) const {
        unsigned char* ws = ws0; ws = GP(ws);
        const float* ss = (const float*)(ws + SS_MIX);
        const int pn = u.pn, rowb = u.pm * 256 + wr * 64 + fr;
        if (pn <= 2) {
            if (pn == 2 && wc >= 2) {
                float rs8[2][4]; rs_rows8(ss, rowb, fq, rs8); EPI_FENCE(); EPI_LOADS_DONE();
                const unsigned ob = (unsigned)rowb * 256u + (unsigned)((wc - 2) * 64 + 8 * fq) * 2u;
                ROWS8 {
#pragma unroll
                    for (int bj = 0; bj < 2; ++bj) sto_bf16x8(ws + WS_V, ob + RO(ai, m) * 256u + 64u * bj, acc[ai][bj][m][0] * rs8[ai][m], acc[ai][bj][m][1] * rs8[ai][m]); }
            } else {
                const float* gn = ((pn == 2) ? inp(6) : inp(5)) + l * 64; const float sc = (pn == 2) ? 1.f : 0.125f;
                const unsigned char* csT = ws + WS_MISC + MISC_COS;
                unsigned gh[2][2][2];
#pragma unroll
                for (int bj = 0; bj < 2; ++bj)
#pragma unroll
                    for (int n = 0; n < 2; ++n) { const f32x4 g = ldo<f32x4>(gn, (unsigned)(32 * bj + 8 * fq + 4 * n) * 4u);
#pragma unroll
                        for (int k = 0; k < 2; ++k) { h16x2 pr; pr[0] = (_Float16)g[2 * k]; pr[1] = (_Float16)g[2 * k + 1]; gh[bj][n][k] = __builtin_bit_cast(unsigned, pr); PIN1(gh[bj][n][k]); } }
                u32x4 pk[2][4][2];
                ROWS8 { f32x4 v[2][2]; u32x4 cs4[2]; float s2 = 0.f; float rs;
                    { const f32x4 a = ldo<f32x4>(ss, ((unsigned)rowb + RO(ai, m)) * 64u + 16u * (unsigned)fq); float q = (a[0] + a[1]) + (a[2] + a[3]); q += shx(q, 16); q += shx(q, 32); rs = rsqrtf(q + EPS * D) * 32.f; }
#pragma unroll
                    for (int n = 0; n < 2; ++n) cs4[n] = ldo<u32x4>(csT, ((unsigned)rowb + RO(ai, m)) * 32u + 16u * n);
#pragma unroll
                    for (int bj = 0; bj < 2; ++bj)
#pragma unroll
                        for (int n = 0; n < 2; ++n) { v[bj][n] = acc[ai][bj][m][n] * rs; const f32x4 q = v[bj][n] * v[bj][n]; s2 += (q[0] + q[1]) + (q[2] + q[3]); }
                    s2 += shx(s2, 16); s2 += shx(s2, 32);
                    const float hr = rsqrtf(s2 + EPS * 64.f) * (8.f * sc);
#pragma unroll
                    for (int bj = 0; bj < 2; ++bj)
#pragma unroll
                        for (int n = 0; n < 2; ++n) {
#pragma unroll
                            for (int k = 0; k < 2; ++k) { unsigned gw = gh[bj][n][k]; PIN1(gw); const h16x2 pr = __builtin_bit_cast(h16x2, gw);
                                v[bj][n][2 * k] = v[bj][n][2 * k] * hr * (float)pr[0]; v[bj][n][2 * k + 1] = v[bj][n][2 * k + 1] * hr * (float)pr[1]; } }
#pragma unroll
                    for (int n = 0; n < 2; ++n) {
#pragma unroll
                        for (int i = 0; i < 4; ++i) { const float x = v[0][n][i]; const float o = shx(x, 16); const unsigned cw = cs4[n][i]; const h16x2 pr = __builtin_bit_cast(h16x2, cw); const float cv = (float)pr[0], sv = (float)pr[1];
                            const float r0 = x * cv - o * sv, r1 = x * cv + o * sv;
                            v[0][n][i] = (fq == 0) ? r0 : ((fq == 1) ? r1 : x); } }
#pragma unroll
                    for (int bj = 0; bj < 2; ++bj) { u32x4 w; w.x = cvt_pk_bf16(v[bj][0][0], v[bj][0][1]); w.y = cvt_pk_bf16(v[bj][0][2], v[bj][0][3]); w.z = cvt_pk_bf16(v[bj][1][0], v[bj][1][1]); w.w = cvt_pk_bf16(v[bj][1][2], v[bj][1][3]);
                        PIN4(w); pk[ai][m][bj] = w; }
                    }
                EPI_FENCE(); EPI_LOADS_DONE();
                unsigned char* dst = (pn == 2) ? (ws + WS_K) : (ws + WS_Q); const unsigned pitch = (pn == 2) ? 256u : 1024u;
                const unsigned ob = (unsigned)rowb * pitch + (unsigned)(((pn == 2) ? wc : (4 * pn + wc)) * 64 + 8 * fq) * 2u;
                ROWS8 {
#pragma unroll
                    for (int bj = 0; bj < 2; ++bj) sto<u32x4>(dst, ob + RO(ai, m) * pitch + 64u * bj, pk[ai][m][bj]); }
            }
        } else {
            const int hd = (pn - 3) >> 1;
            const int cb0 = hd * 128 + 32 * wc + 8 * fq;
            const unsigned ob = (unsigned)rowb * 1024u + (unsigned)cb0 * 2u;
            float rs8[2][4]; rs_rows8(ss, rowb, fq, rs8);
            if (((pn - 3) & 1) == 0) {
                const float* lb = (const float*)(ws + WS_MISC + MISC_LB) + l * 512;
                const f32x4 lbv4[2] = {ldo<f32x4>(lb, (unsigned)cb0 * 4u), ldo<f32x4>(lb, (unsigned)cb0 * 4u + 16u)};
                EPI_FENCE(); EPI_LOADS_DONE();
#pragma unroll
                for (int ai = 0; ai < 2; ++ai) {
                    float chv[8];
                    unsigned qp[4][4], kp[4][4];
#pragma unroll
                    for (int n = 0; n < 2; ++n)
#pragma unroll
                        for (int ip = 0; ip < 2; ++ip) {
                            const int dcol = cb0 + 4 * n + 2 * ip; const float lb0 = lbv4[n][2 * ip], lb1 = lbv4[n][2 * ip + 1];
                            float qh[4][2], kh[4][2], ebr[2], ecc[2], edc[2];
#pragma unroll
                            for (int e = 0; e < 2; ++e) { const int i = 2 * ip + e; const float lbv = e ? lb1 : lb0;
                                float key[4], p[4], tot[4];
#pragma unroll
                                for (int m = 0; m < 4; ++m) { const float z = acc[ai][1][m][n][i] * rs8[ai][m]; const float t = fast_exp(-fmaxf(z, -30.f)), sg = __builtin_amdgcn_rcpf(1.f + t);
                                    key[m] = (1.f - lbv) * (t * sg); float v = __builtin_amdgcn_logf(lbv + (1.f - lbv) * sg) * 0.69314718f;
                                    v += __builtin_bit_cast(float, __builtin_amdgcn_update_dpp(0, __builtin_bit_cast(int, v), 0x111, 0xf, 0xf, true));
                                    v += __builtin_bit_cast(float, __builtin_amdgcn_update_dpp(0, __builtin_bit_cast(int, v), 0x112, 0xf, 0xf, true));
                                    v += __builtin_bit_cast(float, __builtin_amdgcn_update_dpp(0, __builtin_bit_cast(int, v), 0x114, 0xf, 0xf, true));
                                    v += __builtin_bit_cast(float, __builtin_amdgcn_update_dpp(0, __builtin_bit_cast(int, v), 0x118, 0xf, 0xf, true));
                                    p[m] = v; tot[m] = __builtin_bit_cast(float, __builtin_amdgcn_update_dpp(0, __builtin_bit_cast(int, v), 0x15F, 0xf, 0xf, false)); }
                                const float o1 = tot[0], o2 = o1 + tot[1], o3 = o2 + tot[2], blast = o3 + tot[3], bref = o2;
                                const float bb[4] = {p[0], p[1] + o1, p[2] + o2, p[3] + o3};
#pragma unroll
                                for (int m = 0; m < 4; ++m) { const float q = silu(acc[ai][0][m][n][i] * rs8[ai][m]);
                                    qh[m][e] = q * fast_exp(fminf(bb[m] - bref, 80.f)); kh[m][e] = key[m] * fast_exp(fminf(bref - bb[m], 80.f)); }
                                ebr[e] = fast_exp(bref); ecc[e] = fast_exp(blast - bref); edc[e] = fast_exp(blast); }
#pragma unroll
                            for (int m = 0; m < 4; ++m) { qp[m][2 * n + ip] = cvt_pk_bf16(qh[m][0], qh[m][1]); kp[m][2 * n + ip] = cvt_pk_bf16(kh[m][0], kh[m][1]); }
#pragma unroll
                            for (int e = 0; e < 2; ++e) chv[4 * n + 2 * ip + e] = (fr == 0) ? ebr[e] : ((fr == 1) ? ecc[e] : edc[e]);
                            EPI_FENCE();
                        }
                    if (fr < 3) { const unsigned co = (unsigned)((u.pm * 4 + ai * 2 + wr) * 512 + cb0) * 4u + (unsigned)fr * ((unsigned)(M / 64) * 2048u);
                        sto<f32x4>(ws + WS_CHS, co, (f32x4){chv[0], chv[1], chv[2], chv[3]}); sto<f32x4>(ws + WS_CHS, co + 16u, (f32x4){chv[4], chv[5], chv[6], chv[7]}); }
#pragma unroll
                    for (int m = 0; m < 4; ++m) { const unsigned go = ob + RO(ai, m) * 1024u;
                        sto<u32x4>(ws + WS_QR, go, (u32x4){qp[m][0], qp[m][1], qp[m][2], qp[m][3]}); sto<u32x4>(ws + WS_KEY, go, (u32x4){kp[m][0], kp[m][1], kp[m][2], kp[m][3]}); }
                }
            } else {
                EPI_FENCE(); EPI_LOADS_DONE();
                ROWS8 { const float rs = rs8[ai][m];
                    f32x4 a = acc[ai][1][m][0] * rs, b = acc[ai][1][m][1] * rs;
#pragma unroll
                    for (int i = 0; i < 4; ++i) { a[i] = silu(a[i]); b[i] = silu(b[i]); }
                    sto_bf16x8(ws + WS_IR, ob + RO(ai, m) * 1024u, acc[ai][0][m][0] * rs, acc[ai][0][m][1] * rs);
                    sto_bf16x8(ws + WS_GR, ob + RO(ai, m) * 1024u, a, b); }
            }
        }
    }
};

struct EpiResid {
    static constexpr bool PERM = true, F8 = true;
    unsigned char* ws0;
    __device__ __forceinline__ void operator()(f32x4 (&acc)[2][2][4][2], const Unit& u, int wr, int wc, int fr, int fq) const {
        unsigned char* ws = ws0; ws = GP(ws);
        const int rowb = u.pm * 256 + wr * 64 + fr, col0 = u.pn * 256 + wc * 64 + 8 * fq;
        const unsigned ob = ((unsigned)rowb * D + (unsigned)col0) * 2u;
#pragma unroll
        for (int ai = 0; ai < 2; ++ai) { u32x4 r[4][2];
#pragma unroll
            for (int m = 0; m < 4; ++m)
#pragma unroll
                for (int bj = 0; bj < 2; ++bj) r[m][bj] = ldo<u32x4>(ws + WS_HB, ob + RO(ai, m) * (D * 2u) + 64u * bj);
#pragma unroll
            for (int m = 0; m < 4; ++m)
#pragma unroll
                for (int bj = 0; bj < 2; ++bj) { f32x4 ra, rb; up_bf16x8(r[m][bj], ra, rb); acc[ai][bj][m][0] = acc[ai][bj][m][0] * (1.f / (MIX_SCALE * WOUT_SCALE)) + ra; acc[ai][bj][m][1] = acc[ai][bj][m][1] * (1.f / (MIX_SCALE * WOUT_SCALE)) + rb; PIN4(acc[ai][bj][m][0]); PIN4(acc[ai][bj][m][1]); } }
        EPI_FENCE(); EPI_LOADS_DONE();
        float ss8[2][4];
        ROWS8 { float s2 = 0.f; u32x2 f8[2];
#pragma unroll
            for (int bj = 0; bj < 2; ++bj) { const unsigned o = ob + RO(ai, m) * (D * 2u) + 64u * bj;
                const f32x4 va = acc[ai][bj][m][0], vb = acc[ai][bj][m][1]; sto_bf16x8(ws + WS_HB2, o, va, vb); f8[bj] = pk_fp8x8(va, vb); s2 += sq8(va, vb); }
            asm volatile("s_nop 3\n\tv_permlane16_swap_b32 %0, %2\n\ts_nop 1\n\tv_permlane16_swap_b32 %1, %3\n\ts_nop 3" : "+v"(f8[0].x), "+v"(f8[0].y), "+v"(f8[1].x), "+v"(f8[1].y));
            sto<u32x4>(ws + WS_HB2F8, ((ob + RO(ai, m) * (D * 2u)) >> 1) + ((fq & 1) ? 24u : 0u), (u32x4){f8[0].x, f8[0].y, f8[1].x, f8[1].y});
            s2 += shx(s2, 16); s2 += shx(s2, 32); ss8[ai][m] = s2; }
        SS_STORE8(ws + SS_FFN, rowb, u.pn * 4 + wc, ss8);
    }
};
struct EpiMoe1 {
    static constexpr bool PERM = true, F8 = true;
    unsigned char* ws0; const LAS int* cntl;
    __device__ __forceinline__ void operator()(f32x4 (&acc)[2][2][4][2], const Unit& u, int wr, int wc, int fr, int fq) const {
        unsigned char* ws = ws0; ws = GP(ws);
        const int cg = cntl[u.g]; const int rl0 = wr * 64 + fr;
        float rs8[2][4];
        ROWS8 { const int rg = u.mt * 256 + rl0 + (int)RO(ai, m); rs8[ai][m] = ldo<float>(ws + WS_RSL, (unsigned)(u.g * M + (rg < cg ? rg : 0)) * 4u); }
        ROWS8 { PIN1(rs8[ai][m]); }
        EPI_FENCE(); EPI_LOADS_DONE();
        const unsigned ob = (unsigned)(u.pm * 256 + rl0) * FF + (unsigned)(128 * u.pn + 32 * wc + 8 * fq);
#pragma unroll
        for (int ai = 0; ai < 2; ++ai)
#pragma unroll
            for (int mp = 0; mp < 2; ++mp) { u32x2 f8[2];
#pragma unroll
                for (int k = 0; k < 2; ++k) { const int m = 2 * mp + k; const float rs = rs8[ai][m], rh = __builtin_amdgcn_ldexpf(rs, 2)  ; f32x4 h0, h1;
#pragma unroll
                    for (int i = 0; i < 4; ++i) { h0[i] = clamp_f8(silu(acc[ai][0][m][0][i] * rs) * (acc[ai][1][m][0][i] * rh)); h1[i] = clamp_f8(silu(acc[ai][0][m][1][i] * rs) * (acc[ai][1][m][1][i] * rh)); }
                    f8[k] = pk_fp8x8(h0, h1); }
                asm volatile("s_nop 3\n\tv_permlane16_swap_b32 %0, %2\n\ts_nop 1\n\tv_permlane16_swap_b32 %1, %3\n\ts_nop 3" : "+v"(f8[0].x), "+v"(f8[0].y), "+v"(f8[1].x), "+v"(f8[1].y));
                const unsigned o = (fq & 1) ? (ob + RO(ai, 2 * mp + 1) * FF - 8u) : (ob + RO(ai, 2 * mp) * FF);
                sto<u32x4>(ws + WS_HID, o, (u32x4){f8[0].x, f8[0].y, f8[1].x, f8[1].y}); }
    }
};
struct EpiMoe2 {
    static constexpr bool PERM = true, F8 = true;
    unsigned char* ws0; const LAS int* cntl; bool FINAL;
    __device__ __forceinline__ void operator()(f32x4 (&acc)[2][2][4][2], const Unit& u, int wr, int wc, int fr, int fq) const {
        unsigned char* ws = ws0; ws = GP(ws);
        const int cg = cntl[u.g]; const int rl0 = wr * 64 + fr; const unsigned col0 = (unsigned)(u.pn * 256 + wc * 64 + 8 * fq);
        int tok[2][4];
#pragma unroll
        for (int ai = 0; ai < 2; ++ai) { float w[4]; u32x4 r[4][2];
#pragma unroll
            for (int m = 0; m < 4; ++m) { const int rg = u.mt * 256 + rl0 + (int)RO(ai, m); const unsigned li = (unsigned)(u.g * M + (rg < cg ? rg : 0)) * 4u; tok[ai][m] = ldo<int>(ws + WS_TOKL, li); w[m] = ldo<float>(ws + WS_WL, li) * (1.f / (HID_SCALE * WD_SCALE)); }
#pragma unroll
            for (int m = 0; m < 4; ++m)
#pragma unroll
                for (int bj = 0; bj < 2; ++bj) r[m][bj] = ldo<u32x4>(ws + WS_HB2, ((unsigned)tok[ai][m] * D + col0) * 2u + 64u * bj);
#pragma unroll
            for (int m = 0; m < 4; ++m)
#pragma unroll
                for (int bj = 0; bj < 2; ++bj) { f32x4 ra, rb; up_bf16x8(r[m][bj], ra, rb); acc[ai][bj][m][0] = ra + acc[ai][bj][m][0] * w[m]; acc[ai][bj][m][1] = rb + acc[ai][bj][m][1] * w[m]; PIN4(acc[ai][bj][m][0]); PIN4(acc[ai][bj][m][1]); } }
        EPI_FENCE(); EPI_LOADS_DONE();
        ROWS8 { const int rg = u.mt * 256 + rl0 + (int)RO(ai, m); const bool valid = rg < cg; float s2 = 0.f;
            if (valid) {
#pragma unroll
                for (int bj = 0; bj < 2; ++bj) { const f32x4 va = acc[ai][bj][m][0], vb = acc[ai][bj][m][1]; sto_bf16x8(ws + WS_HB2, ((unsigned)tok[ai][m] * D + col0) * 2u + 64u * bj, va, vb); if (FINAL) s2 += sq8(va, vb); }
            }
            if (FINAL) { s2 += shx(s2, 16); s2 += shx(s2, 32); if (fq == 0 && valid) sto<float>(ws + SS_PG, ((unsigned)tok[ai][m] * 16u + (unsigned)(u.pn * 4 + wc)) * 4u, s2); } }
    }
};
struct EpiPle1 {
    static constexpr bool PERM = true, F8 = false;
    unsigned char* ws0;
    __device__ __forceinline__ void operator()(f32x4 (&acc)[2][2][4][2], const Unit& u, int wr, int wc, int fr, int fq) const {
        unsigned char* ws = ws0; ws = GP(ws);
        const int rowb = u.pm * 256 + wr * 64 + fr, col0 = u.pn * 256 + wc * 64 + 8 * fq;
        const unsigned ob = ((unsigned)rowb * D + (unsigned)col0) * 2u;
        EPI_LOADS_DONE();
        float ss8[2][4];
        ROWS8 { float s2 = 0.f;
#pragma unroll
            for (int bj = 0; bj < 2; ++bj) { const f32x4 a = acc[ai][bj][m][0], b = acc[ai][bj][m][1];
                sto_bf16x8(ws + WS_PLERAW, ob + RO(ai, m) * (D * 2u) + 64u * bj, a, b);
                const f32x4 qa = a * a, qb = b * b; s2 += (qa[0] + qa[1]) + (qa[2] + qa[3]) + (qb[0] + qb[1]) + (qb[2] + qb[3]); }
            s2 += shx(s2, 16); s2 += shx(s2, 32); ss8[ai][m] = s2; }
        SS_STORE8(ws + SS_PLE, rowb, u.pn * 4 + wc, ss8);
    }
};
struct EpiPle2 {
    static constexpr bool PERM = true, F8 = false;
    float* outf; unsigned char* ws0; int l;
    __device__ __forceinline__ void operator()(f32x4 (&acc)[2][2][4][2], const Unit& u, int wr, int wc, int fr, int fq) const {
        unsigned char* ws = ws0; ws = GP(ws);
        const float* pgain = inp(18) + l * D;
        const int rowb = u.pm * 256 + wr * 64 + fr, col0 = u.pn * 256 + wc * 64 + 8 * fq;
        const unsigned ob = ((unsigned)rowb * D + (unsigned)col0) * 2u;
        float r8[2][4]; rs_rows8((const float*)(ws + SS_PG), rowb, fq, r8);
        ROWS8 {
#pragma unroll
            for (int bj = 0; bj < 2; ++bj)
#pragma unroll
                for (int n = 0; n < 2; ++n) {
#pragma unroll
                    for (int i = 0; i < 4; ++i) acc[ai][bj][m][n][i] = __builtin_amdgcn_rcpf(1.f + fast_exp(-(acc[ai][bj][m][n][i] * r8[ai][m])));
                    PIN4(acc[ai][bj][m][n]); } }
        EPI_FENCE();
        rs_rows8((const float*)(ws + SS_PLE), rowb, fq, r8);
        f32x4 gn[2][2];
#pragma unroll
        for (int bj = 0; bj < 2; ++bj)
#pragma unroll
            for (int n = 0; n < 2; ++n) gn[bj][n] = ldo<f32x4>(pgain, (unsigned)(col0 + bj * 32 + 4 * n) * 4u);
        EPI_FENCE();
#pragma unroll
        for (int ai = 0; ai < 2; ++ai)
#pragma unroll
            for (int mh = 0; mh < 2; ++mh) { u32x4 rh[2][2], rr[2][2];
#pragma unroll
                for (int m2 = 0; m2 < 2; ++m2)
#pragma unroll
                    for (int bj = 0; bj < 2; ++bj) { const unsigned o = ob + RO(ai, 2 * mh + m2) * (D * 2u) + 64u * bj; rh[m2][bj] = ldo<u32x4>(ws + WS_HB2, o); rr[m2][bj] = ldo<u32x4>(ws + WS_PLERAW, o); }
#pragma unroll
                for (int m2 = 0; m2 < 2; ++m2) { const int m = 2 * mh + m2; const float rp = r8[ai][m];
#pragma unroll
                    for (int bj = 0; bj < 2; ++bj) { f32x4 ha, hb2, pa, pb; up_bf16x8(rh[m2][bj], ha, hb2); up_bf16x8(rr[m2][bj], pa, pb);
                        acc[ai][bj][m][0] = ha + (pa * rp * gn[bj][0]) * acc[ai][bj][m][0]; acc[ai][bj][m][1] = hb2 + (pb * rp * gn[bj][1]) * acc[ai][bj][m][1]; PIN4(acc[ai][bj][m][0]); PIN4(acc[ai][bj][m][1]); } }
                EPI_FENCE(); }
        EPI_LOADS_DONE();
        float ss8[2][4];
        ROWS8 { float s2 = 0.f;
#pragma unroll
            for (int bj = 0; bj < 2; ++bj) { const unsigned o = ob + RO(ai, m) * (D * 2u) + 64u * bj; const f32x4 ha = acc[ai][bj][m][0], hb2 = acc[ai][bj][m][1];
                if (outf) { sto<f32x4>(outf, o * 2u, ha); sto<f32x4>(outf, o * 2u + 16u, hb2); }
                else { sto_bf16x8(ws + WS_HB, o, ha, hb2); s2 += sq8(ha, hb2); } }
            s2 += shx(s2, 16); s2 += shx(s2, 32); ss8[ai][m] = s2; }
        if (!outf) SS_STORE8(ws + SS_MIX, rowb, u.pn * 4 + wc, ss8);
    }
};

struct Args { const float* in[21]; float* out; unsigned char* ws; int ph_lo, ph_hi; };

struct Ctx {
    LAS unsigned char* lds; int tid, lane, wave, G, c, vcu;
    float* h; unsigned char* ws;
};
__device__ __forceinline__ float wave_sum(float v) {
#pragma unroll
    for (int o = 1; o < 64; o <<= 1) v += shx(v, o);
    return v;
}

struct TrItem { const float* W; const float* gain; bf16* WT; int N, Kt, dst_row0, c0, c1, k0; float f8scale; };
__device__ __forceinline__ void tr_load(const TrItem& t, f32x4 (&v)[16], int lane) {
    const int r = lane >> 4, c = lane & 15; const int scol = (c < 8) ? (t.c0 + 4 * c) : (t.c1 + 4 * (c - 8));
#pragma unroll
    for (int i = 0; i < 16; ++i) v[i] = *(const f32x4*)(t.W + (size_t)(t.k0 + 4 * i + r) * t.N + scol);
}
__device__ __forceinline__ void tr_store(const TrItem& t, const f32x4 (&v)[16], LAS float* scr, int lane) {
    const int r = lane >> 4, c = lane & 15;
#pragma unroll
    for (int i = 0; i < 16; ++i) { LAS float* d = scr + (4 * i + r) * 65 + 4 * c; d[0] = v[i][0]; d[1] = v[i][1]; d[2] = v[i][2]; d[3] = v[i][3]; }
    asm volatile("s_waitcnt lgkmcnt(0)" ::: "memory");
    const int kc = lane & 7;
    f32x4 g0 = (f32x4){1.f, 1.f, 1.f, 1.f}, g1 = g0;
    if (t.gain) { g0 = *(const f32x4*)(t.gain + t.k0 + 8 * kc); g1 = *(const f32x4*)(t.gain + t.k0 + 8 * kc + 4); }
    if (t.f8scale != 0.f) { g0 = g0 * t.f8scale; g1 = g1 * t.f8scale; unsigned char* W8 = (unsigned char*)t.WT;
#pragma unroll
        for (int j = 0; j < 8; ++j) { const int n = (lane >> 3) + 8 * j; const LAS float* sp = scr + (8 * kc) * 65 + n;
            const f32x4 a = (f32x4){sp[0 * 65] * g0[0], sp[1 * 65] * g0[1], sp[2 * 65] * g0[2], sp[3 * 65] * g0[3]}, b = (f32x4){sp[4 * 65] * g1[0], sp[5 * 65] * g1[1], sp[6 * 65] * g1[2], sp[7 * 65] * g1[3]};
            *(u32x2*)(W8 + (size_t)(t.dst_row0 + n) * t.Kt + t.k0 + 8 * kc) = pk_fp8x8(a, b); }
    } else {
#pragma unroll
    for (int j = 0; j < 8; ++j) { const int n = (lane >> 3) + 8 * j; const LAS float* sp = scr + (8 * kc) * 65 + n;
        u32x4 o; o.x = cvt_pk_bf16(sp[0 * 65] * g0[0], sp[1 * 65] * g0[1]); o.y = cvt_pk_bf16(sp[2 * 65] * g0[2], sp[3 * 65] * g0[3]);
        o.z = cvt_pk_bf16(sp[4 * 65] * g1[0], sp[5 * 65] * g1[1]); o.w = cvt_pk_bf16(sp[6 * 65] * g1[2], sp[7 * 65] * g1[3]);
        *(u32x4*)(t.WT + (size_t)(t.dst_row0 + n) * t.Kt + t.k0 + 8 * kc) = o; }
    }
    asm volatile("s_waitcnt lgkmcnt(0)" ::: "memory");
}

__device__ __forceinline__ void prologue(Ctx& X) {
    unsigned char* ws = X.ws;
    const int tid = opaque_tid(X.wave), lane = tid & 63, wave = __builtin_amdgcn_readfirstlane(tid >> 6);
    LAS float* scr = (LAS float*)(X.lds + wave * 16640);
    const int gw = X.vcu * 8 + wave, NGW = X.G * 8;
    const float *w_in = inp(4), *w_out = inp(10), *w_gate = inp(14), *w_up = inp(15), *w_down = inp(16), *w_ple = inp(17), *w_pg = inp(20);
    const float *mix_norm = inp(3), *ffn_norm = inp(11), *pg_norm = inp(19);
    constexpr int I_IN = 16 * 44, I_OUT = 16 * 16, I_GU = 32 * 16 * 16, I_D = 32 * 8 * 16, I_PLE = 4 * 16, I_PG = 16 * 16;
    constexpr int I_LAYER = I_IN + I_OUT + I_GU + I_D + I_PLE + I_PG;
#define NCOL(gp) (256 * ((2 * (gp)) >> 3) + 64 * ((2 * (gp)) & 3) + 32 * (((2 * (gp)) >> 2) & 1))
    auto decode = [&](int it, TrItem& t) {
        const int l = it / I_LAYER; int r = it % I_LAYER;
        if (r < I_IN) { const int kb = r / 44, gp = r % 44, gi = 2 * gp, pn = gi >> 3, bj = (gi >> 2) & 1, wc = gi & 3;
            int sc, sc1;
            if (pn <= 2) { sc = 256 * pn + 64 * wc + 32 * bj; sc1 = sc + 64; }
            else { const int hd = (pn - 3) >> 1, tb = (pn - 3) & 1; sc = (tb ? (bj ? 2304 : 1792) : (bj ? 1280 : 768)) + hd * 128 + 32 * wc; sc1 = sc + 32; }
            t = TrItem{w_in + (size_t)l * D * IN_W, mix_norm + l * D, (bf16*)(ws + WS_WIN) + (size_t)l * IN_W * D, IN_W, D, 64 * gp, sc, sc1, 64 * kb, 0.f}; return; }
        r -= I_IN;
        if (r < I_OUT) { const int kb = r / 16, gp = r % 16;
            t = TrItem{w_out + (size_t)l * D * D, nullptr, (bf16*)(ws + WS_WOUT + (size_t)l * D * D), D, D, 64 * gp, NCOL(gp), NCOL(gp) + 64, 64 * kb, WOUT_SCALE}; return; }
        r -= I_OUT;
        if (r < I_GU) { const int e = r / 256, q = r % 256, kb = q / 16, gp = q % 16, gi = 2 * gp, pn = gi >> 3, bj = (gi >> 2) & 1, xg = gi & 3; const int sc = 128 * pn + 32 * xg;
            t = TrItem{(bj ? w_up : w_gate) + (size_t)(l * NEXP + e) * D * FF, ffn_norm + l * D, (bf16*)(ws + WS_WGU + (size_t)(l * NEXP + e) * 1024 * D), FF, D, 64 * gp, sc, sc + 32, 64 * kb, 32.f}; return; }
        r -= I_GU;
        if (r < I_D) { const int e = r / 128, q = r % 128, kb = q / 16, gp = q % 16;
            t = TrItem{w_down + (size_t)(l * NEXP + e) * FF * D, nullptr, (bf16*)(ws + WS_WD + (size_t)(l * NEXP + e) * D * FF), D, FF, 64 * gp, NCOL(gp), NCOL(gp) + 64, 64 * kb, WD_SCALE}; return; }
        r -= I_D;
        if (r < I_PLE) { const int kb = r / 16, gp = r % 16;
            t = TrItem{w_ple + (size_t)l * PLE * D, nullptr, (bf16*)(ws + WS_WPLE) + (size_t)l * D * PLE, D, PLE, 64 * gp, NCOL(gp), NCOL(gp) + 64, 64 * kb, 0.f}; return; }
        r -= I_PLE;
        { const int kb = r / 16, gp = r % 16;
            t = TrItem{w_pg + (size_t)l * D * D, pg_norm + l * D, (bf16*)(ws + WS_WPG) + (size_t)l * D * D, D, D, 64 * gp, NCOL(gp), NCOL(gp) + 64, 64 * kb, 0.f}; }
    };
    {
        f32x4 cur[16], nxt[16]; TrItem tc, tn; int it = gw;
        if (it < DEPTH * I_LAYER) { decode(it, tc); tr_load(tc, cur, lane); }
        while (it < DEPTH * I_LAYER) {
            const int itn = it + NGW; const bool more = itn < DEPTH * I_LAYER;
            if (more) { decode(itn, tn); tr_load(tn, nxt, lane); }
            tr_store(tc, cur, scr, lane);
            if (more) { tc = tn;
#pragma unroll
                for (int i = 0; i < 16; ++i) cur[i] = nxt[i]; }
            it = itn;
        }
    }
    const int gt = X.vcu * 512 + tid, NGT = X.G * 512;
    { const float *w_rg = inp(12), *w_re = inp(13); bf16* WR = (bf16*)(ws + WS_WR);
      for (int i = gt; i < DEPTH * 64 * D; i += NGT) { const int l = i / (64 * D), j = (i / D) % 64, k = i % D; float v = 0.f;
          if (j < 4) v = w_rg[((size_t)l * D + k) * 4 + j]; else if (j < 36) v = w_re[((size_t)l * D + k) * 32 + (j - 4)];
          WR[i] = (bf16)f2bf(v * ffn_norm[l * D + k]); } }
    { const f32x4* p4 = (const f32x4*)inp(1); u32x2* o = (u32x2*)(ws + WS_PB);
      for (size_t i = gt; i < (size_t)DEPTH * M * PLE / 4; i += NGT) { const f32x4 v = p4[i]; u32x2 w; w.x = pk2(v[0], v[1]); w.y = pk2(v[2], v[3]); o[i] = w; } }
    { const int* pos = (const int*)inp(2); float* cosT = (float*)(ws + WS_MISC + MISC_COS);
      for (int i = gt; i < M * 8; i += NGT) { const int j = i & 7; const int t = i >> 3;
          const double f = (j == 0) ? 1.0 : (j == 1) ? 0.19392274474868576 : (j == 2) ? 0.03760603093086393 : (j == 3) ? 0.007292664737217109 : (j == 4) ? 0.001414213562373095 : (j == 5) ? 0.0002742481756762073 : (j == 6) ? 5.318295896944988e-05 : 1.031338537721246e-05;
          const double x = (double)pos[t] * f; const double q = __builtin_rint(x * 0.6366197723675814); const double rr = (x - q * 1.5707963267948966) - q * 6.123233995736766e-17;
          const double r2 = rr * rr;
          double sn = rr * (1.0 + r2 * (-1.0 / 6 + r2 * (1.0 / 120 + r2 * (-1.0 / 5040 + r2 * (1.0 / 362880 + r2 * (-1.0 / 39916800 + r2 * (1.0 / 6227020800.0)))))));
          double cs = 1.0 + r2 * (-0.5 + r2 * (1.0 / 24 + r2 * (-1.0 / 720 + r2 * (1.0 / 40320 + r2 * (-1.0 / 3628800 + r2 * (1.0 / 479001600.0 + r2 * (-1.0 / 87178291200.0)))))));
          const int qi = (int)((long long)q & 3);
          const double s_ = (qi == 0) ? sn : (qi == 1) ? cs : (qi == 2) ? -sn : -cs;
          const double c_ = (qi == 0) ? cs : (qi == 1) ? -sn : (qi == 2) ? -cs : sn;
          h16x2 pr; pr[0] = (_Float16)(float)c_; pr[1] = (_Float16)(float)s_; ((unsigned*)cosT)[i] = __builtin_bit_cast(unsigned, pr); } }
    { const float* lbl = inp(8); float* LB = (float*)(ws + WS_MISC + MISC_LB);
      for (int i = gt; i < 512; i += NGT) { const float a0 = lbl[i], a1 = lbl[512 + i], a2 = lbl[1024 + i], a3 = lbl[1536 + i]; const float mx = fmaxf(fmaxf(a0, a1), fmaxf(a2, a3));
          const float e0 = __expf(a0 - mx), e1 = __expf(a1 - mx), e2 = __expf(a2 - mx), e3 = __expf(a3 - mx); const float inv = 1.f / (e0 + e1 + e2 + e3);
          LB[i] = 0.f; LB[512 + i] = e1 * inv; LB[1024 + i] = (e1 + e2) * inv; LB[1536 + i] = (e1 + e2 + e3) * inv; } }
    { const float* x = inp(0); bf16* HB = (bf16*)(ws + WS_HB); float* ss = (float*)(ws + SS_MIX);
      for (int m = gw; m < M; m += NGW) { const f32x4* xr = (const f32x4*)(x + (size_t)m * D) + lane; u32x2* br = (u32x2*)(HB + (size_t)m * D) + lane; float s = 0.f;
#pragma unroll
          for (int j = 0; j < 4; ++j) { const f32x4 v = xr[64 * j]; u32x2 w; w.x = pk2(v[0], v[1]); w.y = pk2(v[2], v[3]); br[64 * j] = w; s += (v[0] * v[0] + v[1] * v[1]) + (v[2] * v[2] + v[3] * v[3]); }
          s = wave_sum(s); if (lane < 16) ss[(size_t)m * 16 + lane] = (lane == 0) ? s : 0.f; } }
}

__device__ __forceinline__ int crow(int reg, int h) { return (reg & 3) + 8 * (reg >> 2) + 4 * h; }
__device__ __forceinline__ void tr_read2(unsigned a0, unsigned a1, s16x4& r0, s16x4& r1) {
    asm volatile("ds_read_b64_tr_b16 %0, %2\n\tds_read_b64_tr_b16 %1, %3\n\ts_waitcnt lgkmcnt(0)" : "=&v"(r0), "=&v"(r1) : "v"(a0), "v"(a1) : "memory");
}
__device__ __forceinline__ void attn_phase(Ctx& X, int layer) {
    const bf16* Q = (const bf16*)(X.ws + WS_Q); const bf16* Kb = (const bf16*)(X.ws + WS_K); const bf16* Vb = (const bf16*)(X.ws + WS_V); bf16* MIX = (bf16*)(X.ws + WS_MIX);
    const float* sinks = inp(7) + layer * 8;
    LAS bf16* Ks = (LAS bf16*)X.lds; LAS bf16* Vs = (LAS bf16*)(X.lds + 36864);
    const unsigned vs_base = (unsigned)(size_t)Vs;
    const int tid = opaque_tid(X.wave), lane = tid & 63, wid = __builtin_amdgcn_readfirstlane(tid >> 6), r = lane & 31, hh = lane >> 5;
    const int tq = (lane & 15) >> 2, tp = lane & 3, dsub = (lane >> 4) & 1;
#pragma unroll 1
    for (int unit = X.c; unit < 512; unit += X.G) {
        const int b = unit >> 7, rem = unit & 127, nblk = rem >> 1, kvh = rem & 1;
        const int m0 = b * SEQ + nblk * 128;
        __syncthreads();
#pragma unroll
        for (int j = 0; j < 4; ++j) { const int idx = tid + 512 * j, key = idx >> 3, ch = idx & 7; const bool valid = (nblk > 0) || (key >= 128);
            u32x4 kv = (u32x4){0u, 0u, 0u, 0u}, vv = (u32x4){0u, 0u, 0u, 0u};
            if (valid) { const size_t o = (size_t)(m0 - 128 + key) * 128 + kvh * 64 + ch * 8; kv = *(const u32x4*)(Kb + o); vv = *(const u32x4*)(Vb + o); }
            *(LAS u32x4*)(Ks + key * 72 + ch * 8) = kv; *(LAS u32x4*)(Vs + key * 72 + ch * 8) = vv; }
        __syncthreads();
#pragma unroll 1
        for (int tt = 0; tt < 2; ++tt) {
            const int task = wid + 8 * tt, hl = task & 3, qs = task >> 2, hq = kvh * 4 + hl;
            const float sink = sinks[hq];
            bf16x8 qf[4];
#pragma unroll
            for (int ks = 0; ks < 4; ++ks) qf[ks] = *(const bf16x8*)(Q + (size_t)(m0 + 32 * qs + r) * 512 + hq * 64 + 16 * ks + 8 * hh);
            f32x16 s[5];
#pragma unroll
            for (int kt = 0; kt < 5; ++kt) {
#pragma unroll
                for (int i = 0; i < 16; ++i) s[kt][i] = 0.f;
#pragma unroll
                for (int ks = 0; ks < 4; ++ks) { const bf16x8 kf = *(const LAS bf16x8*)(Ks + (32 * (qs + kt) + r) * 72 + 16 * ks + 8 * hh); s[kt] = MFMA32(kf, qf[ks], s[kt]); }
            }
            const int qi = 32 * qs + r; float mx = sink;
#pragma unroll
            for (int kt = 0; kt < 5; ++kt)
#pragma unroll
                for (int i = 0; i < 16; ++i) { const int kj = 32 * (qs + kt) + crow(i, hh); const bool ok = (kj > qi) && (kj <= qi + 128) && ((nblk > 0) || (kj >= 128));
                    const float v = ok ? s[kt][i] : -1e30f; s[kt][i] = v; mx = fmaxf(mx, v); }
            mx = fmaxf(mx, shx(mx, 32));
            float sum = 0.f;
#pragma unroll
            for (int kt = 0; kt < 5; ++kt)
#pragma unroll
                for (int i = 0; i < 16; ++i) { const float e = fast_exp(s[kt][i] - mx); s[kt][i] = e; sum += e; }
            sum += shx(sum, 32);
            const float inv = __builtin_amdgcn_rcpf(sum + fast_exp(sink - mx));
            f32x16 o[2];
#pragma unroll
            for (int i = 0; i < 16; ++i) { o[0][i] = 0.f; o[1][i] = 0.f; }
#pragma unroll
            for (int kt = 0; kt < 5; ++kt)
#pragma unroll
                for (int st = 0; st < 2; ++st) {
                    u32x4 pw; pw.x = cvt_pk_bf16(s[kt][8 * st + 0], s[kt][8 * st + 1]); pw.y = cvt_pk_bf16(s[kt][8 * st + 2], s[kt][8 * st + 3]);
                    pw.z = cvt_pk_bf16(s[kt][8 * st + 4], s[kt][8 * st + 5]); pw.w = cvt_pk_bf16(s[kt][8 * st + 6], s[kt][8 * st + 7]);
                    const bf16x8 pb = __builtin_bit_cast(bf16x8, pw);
                    const int key0 = 32 * (qs + kt) + 16 * st + 4 * hh;
#pragma unroll
                    for (int nt = 0; nt < 2; ++nt) { s16x4 lo, hi; const unsigned va = vs_base + (unsigned)((key0 + tq) * 72 + 32 * nt + 16 * dsub + 4 * tp) * 2u;
                        tr_read2(va, va + 8 * 72 * 2, lo, hi);
                        const bf16x8 vt = __builtin_shufflevector(lo, hi, 0, 1, 2, 3, 4, 5, 6, 7);
                        o[nt] = MFMA32(vt, pb, o[nt]); }
                }
            unsigned char* orow = (unsigned char*)MIX + (size_t)(m0 + 32 * qs + r) * D + hq * 64 + 8 * hh;
            const float invs = __builtin_amdgcn_ldexpf(inv, 2)  ;
#pragma unroll
            for (int nt = 0; nt < 2; ++nt)
#pragma unroll
                for (int gp = 0; gp < 2; ++gp) { const int g0 = 2 * gp, g1 = 2 * gp + 1;
                    int wa = __builtin_amdgcn_cvt_pk_fp8_f32(clamp_f8(o[nt][4 * g0] * invs), clamp_f8(o[nt][4 * g0 + 1] * invs), 0, false); wa = __builtin_amdgcn_cvt_pk_fp8_f32(clamp_f8(o[nt][4 * g0 + 2] * invs), clamp_f8(o[nt][4 * g0 + 3] * invs), wa, true);
                    int wb = __builtin_amdgcn_cvt_pk_fp8_f32(clamp_f8(o[nt][4 * g1] * invs), clamp_f8(o[nt][4 * g1 + 1] * invs), 0, false); wb = __builtin_amdgcn_cvt_pk_fp8_f32(clamp_f8(o[nt][4 * g1 + 2] * invs), clamp_f8(o[nt][4 * g1 + 3] * invs), wb, true);
                    asm volatile("s_nop 3\n\tv_permlane32_swap_b32 %0, %1\n\ts_nop 3" : "+v"(wa), "+v"(wb));
                    *(u32x2*)(orow + 32 * nt + 16 * gp) = (u32x2){(unsigned)wa, (unsigned)wb}; }
        }
    }
}

constexpr int HG_P = 136;
constexpr int HG_QH = 0, HG_KH = 17408, HG_V = 34816, HG_AL = 52224, HG_OL = 61440, HG_SC = 95232;
__device__ __forceinline__ void tr_read4(unsigned a0, unsigned a1, unsigned a2, unsigned a3, s16x4& r0, s16x4& r1, s16x4& r2, s16x4& r3) {
    asm volatile("ds_read_b64_tr_b16 %0, %4\n\tds_read_b64_tr_b16 %1, %5\n\tds_read_b64_tr_b16 %2, %6\n\tds_read_b64_tr_b16 %3, %7\n\ts_waitcnt lgkmcnt(0)"
                 : "=&v"(r0), "=&v"(r1), "=&v"(r2), "=&v"(r3) : "v"(a0), "v"(a1), "v"(a2), "v"(a3) : "memory");
}
template <bool PASS2>
__device__ __forceinline__ void hgrn_pass(Ctx& X, int layer) {
    const bf16* QHg = (const bf16*)(X.ws + WS_QR); const bf16* KHg = (const bf16*)(X.ws + WS_KEY); const bf16* Vg = (const bf16*)(X.ws + WS_IR); const bf16* GR = (const bf16*)(X.ws + WS_GR);
    const float* CHS = (const float*)(X.ws + WS_CHS); float* USUP = (float*)(X.ws + WS_USUP); float* DSUP = (float*)(X.ws + WS_MISC + MISC_DSUP); bf16* MIX = (bf16*)(X.ws + WS_MIX);
    const float* rnorm = inp(9) + layer * 128;
    LAS unsigned char* lds = X.lds;
    LAS bf16* QHs = (LAS bf16*)(lds + HG_QH); LAS bf16* KHs = (LAS bf16*)(lds + HG_KH); LAS bf16* Vs = (LAS bf16*)(lds + HG_V); LAS bf16* AL = (LAS bf16*)(lds + HG_AL);
    LAS float* OL = (LAS float*)(lds + HG_OL); LAS float* SC = (LAS float*)(lds + HG_SC);
    const int tid = opaque_tid(X.wave), lane = tid & 63, wid = __builtin_amdgcn_readfirstlane(tid >> 6), r16 = lane & 15, g4 = lane >> 4;
    const int prow = tid >> 4, pc16 = tid & 15;
    const unsigned vs_base = (unsigned)(size_t)Vs, kh_base = (unsigned)(size_t)KHs;
    const int tq = (lane & 15) >> 2, tp = lane & 3;
#pragma unroll 1
    for (int unit = X.c; unit < 512; unit += X.G) {
        const int bh = unit >> 5, sc = unit & 31, b = bh >> 2, hd = bh & 3;
        const int m0 = b * SEQ + sc * 256, cb = hd * 128;
        f32x4 S[8];
#pragma unroll
        for (int mt = 0; mt < 8; ++mt) S[mt] = (f32x4){0.f, 0.f, 0.f, 0.f};
        if (PASS2 && sc > 0) {
#pragma unroll
            for (int mt = 0; mt < 8; ++mt) S[mt] = *(const f32x4*)(USUP + ((size_t)unit * 128 + 16 * wid + r16) * 128 + 16 * mt + 4 * g4);
        }
        float dprod = 1.f;
        u32x4 pq[2], pk[2], pv[2]; float psc[3] = {0.f, 0.f, 0.f};
        {
            const size_t g0 = (size_t)(m0 + prow) * 512 + cb + 8 * pc16, g1 = g0 + (size_t)32 * 512;
            pk[0] = *(const u32x4*)(KHg + g0); pk[1] = *(const u32x4*)(KHg + g1); pv[0] = *(const u32x4*)(Vg + g0); pv[1] = *(const u32x4*)(Vg + g1);
            if (PASS2) { pq[0] = *(const u32x4*)(QHg + g0); pq[1] = *(const u32x4*)(QHg + g1); }
            if (tid < 128) { const size_t co = (size_t)(m0 >> 6) * 512 + cb + tid;
#pragma unroll
                for (int k = 0; k < 3; ++k) psc[k] = CHS[(size_t)k * (M / 64) * 512 + co]; }
        }
        __syncthreads();
#pragma unroll 1
        for (int ch = 0; ch < 4; ++ch) {
            const int row0 = m0 + 64 * ch;
            *(LAS u32x4*)(KHs + prow * HG_P + 8 * pc16) = pk[0]; *(LAS u32x4*)(KHs + (prow + 32) * HG_P + 8 * pc16) = pk[1];
            *(LAS u32x4*)(Vs + prow * HG_P + 8 * pc16) = pv[0]; *(LAS u32x4*)(Vs + (prow + 32) * HG_P + 8 * pc16) = pv[1];
            if (PASS2) { *(LAS u32x4*)(QHs + prow * HG_P + 8 * pc16) = pq[0]; *(LAS u32x4*)(QHs + (prow + 32) * HG_P + 8 * pc16) = pq[1]; }
            if (tid < 128) { SC[tid] = psc[0]; SC[128 + tid] = psc[1]; SC[256 + tid] = psc[2]; dprod *= psc[2]; }
            __syncthreads();
            if (ch < 3) {
                const size_t g0 = (size_t)(row0 + 64 + prow) * 512 + cb + 8 * pc16, g1 = g0 + (size_t)32 * 512;
                pk[0] = *(const u32x4*)(KHg + g0); pk[1] = *(const u32x4*)(KHg + g1); pv[0] = *(const u32x4*)(Vg + g0); pv[1] = *(const u32x4*)(Vg + g1);
                if (PASS2) { pq[0] = *(const u32x4*)(QHg + g0); pq[1] = *(const u32x4*)(QHg + g1); }
                if (tid < 128) { const size_t co = (size_t)((row0 + 64) >> 6) * 512 + cb + tid;
#pragma unroll
                    for (int k = 0; k < 3; ++k) psc[k] = CHS[(size_t)k * (M / 64) * 512 + co]; }
            }
            bf16x8 vf[2];
            { s16x4 a0, a1, a2, a3; const unsigned va = vs_base + (unsigned)((8 * g4 + tq) * HG_P + 16 * wid + 4 * tp) * 2u;
              tr_read4(va, va + 4 * HG_P * 2, va + 32 * HG_P * 2, va + 36 * HG_P * 2, a0, a1, a2, a3);
              vf[0] = __builtin_shufflevector(a0, a1, 0, 1, 2, 3, 4, 5, 6, 7); vf[1] = __builtin_shufflevector(a2, a3, 0, 1, 2, 3, 4, 5, 6, 7); }
            if (PASS2) {
#pragma unroll
                for (int q2 = 0; q2 < 2; ++q2) { const int tile = 2 * wid + q2, ti = tile >> 2, si = tile & 3; f32x4 a4 = (f32x4){0.f, 0.f, 0.f, 0.f};
                    if (si <= ti) {
#pragma unroll
                        for (int ks = 0; ks < 4; ++ks) { const bf16x8 af = *(const LAS bf16x8*)(QHs + (16 * ti + r16) * HG_P + 32 * ks + 8 * g4), bfr = *(const LAS bf16x8*)(KHs + (16 * si + r16) * HG_P + 32 * ks + 8 * g4); a4 = MFMA16(af, bfr, a4); }
                    }
#pragma unroll
                    for (int rg = 0; rg < 4; ++rg) { const int t = 16 * ti + 4 * g4 + rg, s_ = 16 * si + r16; AL[t * 72 + s_] = (bf16)f2bf((s_ <= t) ? a4[rg] : 0.f); } }
                __syncthreads();
                f32x4 o[4];
#pragma unroll
                for (int mt = 0; mt < 4; ++mt) { o[mt] = (f32x4){0.f, 0.f, 0.f, 0.f};
#pragma unroll
                    for (int ks = 0; ks < 2; ++ks) { const bf16x8 af = *(const LAS bf16x8*)(AL + (16 * mt + r16) * 72 + 32 * ks + 8 * g4); o[mt] = MFMA16(af, vf[ks], o[mt]); } }
#pragma unroll
                for (int k2 = 0; k2 < 4; ++k2) { const f32x4 e0 = *(const LAS f32x4*)(SC + 32 * k2 + 4 * g4), e1 = *(const LAS f32x4*)(SC + 32 * k2 + 16 + 4 * g4);
                    const f32x4 s0 = S[2 * k2] * e0, s1 = S[2 * k2 + 1] * e1;
                    u32x4 sw; sw.x = cvt_pk_bf16(s0[0], s0[1]); sw.y = cvt_pk_bf16(s0[2], s0[3]); sw.z = cvt_pk_bf16(s1[0], s1[1]); sw.w = cvt_pk_bf16(s1[2], s1[3]);
                    const bf16x8 sb = __builtin_bit_cast(bf16x8, sw);
#pragma unroll
                    for (int mt = 0; mt < 4; ++mt) { const LAS bf16* qp = QHs + (16 * mt + r16) * HG_P + 32 * k2 + 4 * g4; const s16x4 lo = *(const LAS s16x4*)qp, hi = *(const LAS s16x4*)(qp + 16);
                        const bf16x8 af = __builtin_shufflevector(lo, hi, 0, 1, 2, 3, 4, 5, 6, 7); o[mt] = MFMA16(af, sb, o[mt]); } }
#pragma unroll
                for (int mt = 0; mt < 4; ++mt)
#pragma unroll
                    for (int rg = 0; rg < 4; ++rg) OL[(16 * mt + 4 * g4 + rg) * 132 + 16 * wid + r16] = o[mt][rg];
            }
#pragma unroll
            for (int mt = 0; mt < 8; ++mt) { s16x4 a0, a1, a2, a3; const unsigned ka = kh_base + (unsigned)((8 * g4 + tq) * HG_P + 16 * mt + 4 * tp) * 2u;
                tr_read4(ka, ka + 4 * HG_P * 2, ka + 32 * HG_P * 2, ka + 36 * HG_P * 2, a0, a1, a2, a3);
                const bf16x8 k0 = __builtin_shufflevector(a0, a1, 0, 1, 2, 3, 4, 5, 6, 7), k1 = __builtin_shufflevector(a2, a3, 0, 1, 2, 3, 4, 5, 6, 7);
                f32x4 T = (f32x4){0.f, 0.f, 0.f, 0.f}; T = MFMA16(k0, vf[0], T); T = MFMA16(k1, vf[1], T);
                const f32x4 ccv = *(const LAS f32x4*)(SC + 128 + 16 * mt + 4 * g4), dcv = *(const LAS f32x4*)(SC + 256 + 16 * mt + 4 * g4);
                S[mt] = S[mt] * dcv + T * ccv; }
            __syncthreads();
            if (PASS2) {
                const int t = tid >> 3, e0 = (tid & 7) * 16; f32x4 v[4]; float s2 = 0.f;
#pragma unroll
                for (int j = 0; j < 4; ++j) { v[j] = *(const LAS f32x4*)(OL + t * 132 + e0 + 4 * j); const f32x4 q = v[j] * v[j]; s2 += (q[0] + q[1]) + (q[2] + q[3]); }
                s2 += shx(s2, 1); s2 += shx(s2, 2); s2 += shx(s2, 4);
                const float rs = rsqrtf(s2 + EPS * 128.f) * 11.313708499f;
                const size_t go = (size_t)(row0 + t) * 512 + cb + e0;
                f32x4 ga, gb, gc, gd; ld_bf16x8(GR + go, ga, gb); ld_bf16x8(GR + go + 8, gc, gd);
                const f32x4 r0 = *(const f32x4*)(rnorm + e0), r1 = *(const f32x4*)(rnorm + e0 + 4), r2 = *(const f32x4*)(rnorm + e0 + 8), r3 = *(const f32x4*)(rnorm + e0 + 12);
                unsigned char* dst = (unsigned char*)MIX + (size_t)(row0 + t) * D + 512 + cb + e0;
                const float rss = __builtin_amdgcn_ldexpf(rs, 2)  ; f32x4 y[4] = {v[0] * rss * r0 * ga, v[1] * rss * r1 * gb, v[2] * rss * r2 * gc, v[3] * rss * r3 * gd};
#pragma unroll
                for (int j = 0; j < 4; ++j)
#pragma unroll
                    for (int i = 0; i < 4; ++i) y[j][i] = clamp_f8(y[j][i]);
                const u32x2 w0 = pk_fp8x8(y[0], y[1]), w1 = pk_fp8x8(y[2], y[3]);
                *(u32x4*)dst = (u32x4){w0.x, w0.y, w1.x, w1.y};
            }
        }
        if (!PASS2) {
#pragma unroll
            for (int mt = 0; mt < 8; ++mt) *(f32x4*)(USUP + ((size_t)unit * 128 + 16 * wid + r16) * 128 + 16 * mt + 4 * g4) = S[mt];
            if (tid < 128) DSUP[unit * 128 + tid] = dprod;
        }
    }
}
__device__ __forceinline__ void hgrn_scan(Ctx& X) {
    float* USUP = (float*)(X.ws + WS_USUP); const float* DSUP = (const float*)(X.ws + WS_MISC + MISC_DSUP);
    const int tid = opaque_tid(X.wave);
    for (int item = X.c * 512 + tid; item < 16 * 4096; item += X.G * 512) {
        const int bh = item >> 12, idx = item & 4095, e = idx >> 5, dk4 = (idx & 31) * 4;
        f32x4 s = (f32x4){0.f, 0.f, 0.f, 0.f};
        for (int s0 = 0; s0 < 32; s0 += 8) {
            f32x4 uv[8], dv[8];
#pragma unroll
            for (int j = 0; j < 8; ++j) { const int u = bh * 32 + s0 + j; uv[j] = *(const f32x4*)(USUP + ((size_t)u * 128 + e) * 128 + dk4); dv[j] = *(const f32x4*)(DSUP + u * 128 + dk4); }
#pragma unroll
            for (int j = 0; j < 8; ++j) { const int u = bh * 32 + s0 + j; *(f32x4*)(USUP + ((size_t)u * 128 + e) * 128 + dk4) = s; s = s * dv[j] + uv[j]; }
        }
    }
}

__device__ __forceinline__ void router_phase(Ctx& X, int layer) {
    const bf16* HB = (const bf16*)(X.ws + WS_HB2); const bf16* WR = (const bf16*)(X.ws + WS_WR) + (size_t)layer * 64 * D;
    const float* ssf = (const float*)(X.ws + SS_FFN);
    unsigned* CNT = (unsigned*)(X.ws + WS_CTL) + CW_CNT; int* TOKL = (int*)(X.ws + WS_TOKL); float* WL = (float*)(X.ws + WS_WL); float* RSL = (float*)(X.ws + WS_RSL);
    LAS bf16* WRs = (LAS bf16*)X.lds;
    LAS float* LOG = (LAS float*)(X.lds + 99328);
    LAS unsigned* HIST = (LAS unsigned*)(X.lds + 124672); LAS unsigned* BASE = (LAS unsigned*)(X.lds + 124928);
    const int tid = opaque_tid(X.wave), lane = tid & 63, wid = __builtin_amdgcn_readfirstlane(tid >> 6), r16 = lane & 15, g4 = lane >> 4;
    __syncthreads();
#pragma unroll
    for (int j = 0; j < 12; ++j) { const int p = tid + 512 * j, row = p >> 7, c16 = p & 127; *(LAS u32x4*)(WRs + row * 1032 + 8 * c16) = *(const u32x4*)(WR + (size_t)row * D + 8 * c16); }
    __syncthreads();
    for (int bt = X.c; bt < M / 128; bt += X.G) {
        const int tok0 = bt * 128 + wid * 16;
        f32x4 acc[3];
#pragma unroll
        for (int nt = 0; nt < 3; ++nt) acc[nt] = (f32x4){0.f, 0.f, 0.f, 0.f};
#pragma unroll 1
        for (int kh = 0; kh < 2; ++kh) { bf16x8 a[16];
#pragma unroll
            for (int k = 0; k < 16; ++k) a[k] = *(const bf16x8*)(HB + (size_t)(tok0 + r16) * D + 32 * (16 * kh + k) + 8 * g4);
#pragma unroll
            for (int k = 0; k < 16; ++k)
#pragma unroll
                for (int nt = 0; nt < 3; ++nt) { const bf16x8 bq = *(const LAS bf16x8*)(WRs + (16 * nt + r16) * 1032 + 32 * (16 * kh + k) + 8 * g4); acc[nt] = MFMA16(a[k], bq, acc[nt]); } }
#pragma unroll
        for (int nt = 0; nt < 3; ++nt)
#pragma unroll
            for (int rg = 0; rg < 4; ++rg) LOG[(wid * 16 + 4 * g4 + rg) * 49 + 16 * nt + r16] = acc[nt][rg];
        if (tid < 64) HIST[tid] = 0u;
        __syncthreads();
        int G0 = 0, G1 = 0; unsigned lr0 = 0, lr1 = 0; float w0 = 0.f, w1 = 0.f, rsl = 0.f; const int tok = tok0 + lane;
        if (lane < 16) {
            const LAS float* lg = LOG + (wid * 16 + lane) * 49; const float rs = rsqrtf(ss_row(ssf, tok) + EPS * D) * 32.f; rsl = rs * (1.f / 32.f);
            float gl[4];
#pragma unroll
            for (int j = 0; j < 4; ++j) gl[j] = lg[j] * rs;
            int gi = 0; float gm = gl[0];
#pragma unroll
            for (int j = 1; j < 4; ++j) if (gl[j] > gm) { gm = gl[j]; gi = j; }
            float gs = 0.f;
#pragma unroll
            for (int j = 0; j < 4; ++j) gs += __expf(gl[j] - gm);
            const float pg = 1.f / gs;
            const LAS float* le = lg + 4 + 8 * gi;
            float el[8];
#pragma unroll
            for (int j = 0; j < 8; ++j) el[j] = le[j] * rs;
            int i1 = 0; float v1 = el[0];
#pragma unroll
            for (int j = 1; j < 8; ++j) if (el[j] > v1) { v1 = el[j]; i1 = j; }
            int i2 = -1; float v2 = -3.0e38f;
#pragma unroll
            for (int j = 0; j < 8; ++j) if (j != i1 && el[j] > v2) { v2 = el[j]; i2 = j; }
            const float ex = __expf(v2 - v1); const float s1 = 1.f / (1.f + ex);
            w0 = pg * s1; w1 = pg * (ex * s1);
            G0 = gi * 8 + i1; G1 = 32 + gi * 8 + i2;
            lr0 = __hip_atomic_fetch_add(&HIST[G0], 1u, __ATOMIC_RELAXED, __HIP_MEMORY_SCOPE_WORKGROUP); lr1 = __hip_atomic_fetch_add(&HIST[G1], 1u, __ATOMIC_RELAXED, __HIP_MEMORY_SCOPE_WORKGROUP);
        }
        __syncthreads();
        if (tid < 64) { const unsigned n = HIST[tid]; BASE[tid] = n ? atomicAdd(&CNT[tid], n) : 0u; }
        __syncthreads();
        if (lane < 16) { const unsigned p0 = BASE[G0] + lr0, p1 = BASE[G1] + lr1;
            TOKL[(size_t)G0 * M + p0] = tok; WL[(size_t)G0 * M + p0] = w0; RSL[(size_t)G0 * M + p0] = rsl; TOKL[(size_t)G1 * M + p1] = tok; WL[(size_t)G1 * M + p1] = w1; RSL[(size_t)G1 * M + p1] = rsl; }
        __syncthreads();
    }
}
__device__ __forceinline__ void moe_tables(Ctx& X) {
    const unsigned* CNT = (const unsigned*)(X.ws + WS_CTL) + CW_CNT;
    LAS int* PRE = (LAS int*)(X.lds + LC_PRE); LAS int* CNTL = (LAS int*)(X.lds + LC_CNT);
    const int tid = opaque_tid(X.wave);
    __syncthreads();
    if (tid < 64) CNTL[tid] = (int)__hip_atomic_load(CNT + tid, __ATOMIC_RELAXED, __HIP_MEMORY_SCOPE_AGENT);
    __syncthreads();
    if (tid < 64) { int a = 0;
#pragma unroll 8
        for (int g = 0; g < NGRP; ++g) { const int t = (CNTL[g] + 255) >> 8; a += (g <= tid) ? t : 0; }
        PRE[tid + 1] = a; if (tid == 0) PRE[0] = 0; }
    __syncthreads();
}

__global__ void __launch_bounds__(512, 2) hymba_fwd(Args args) {
    extern __shared__ __attribute__((aligned(16))) unsigned char smem[];
    Ctx X;
    X.lds = (LAS unsigned char*)smem; X.tid = 0; X.lane = 0; X.wave = __builtin_amdgcn_readfirstlane((int)threadIdx.x >> 6);
    X.G = gridDim.x; X.c = blockIdx.x; { const int bx = blockIdx.x; X.vcu = (X.G % 8 == 0) ? (bx % 8) * (X.G / 8) + bx / 8 : bx; }
    X.h = GP(args.out); X.ws = GP(args.ws);
    unsigned char* ws0 = GP(args.ws);
    for (int u = threadIdx.x; u < (LDS_BYTES - LC_BASE) / 4; u += 512) ((LAS unsigned*)(X.lds + LC_BASE))[u] = 0u;
    __syncthreads();
    const int lo = args.ph_lo, hi = args.ph_hi;
    const bool multi = (hi - lo) > 1;
    XcdBarrier bar; bar.bar = (unsigned*)(ws0 + WS_CTL) + CW_BAR; bar.x = 0; bar.st = nullptr;
    if (multi) bar = xcd_barrier_post((unsigned*)(ws0 + WS_CTL) + CW_BAR, (volatile LAS unsigned*)(X.lds + LC_BAR));
#ifndef PH_MASK
#define PH_MASK 0x7ff
#endif
#define PHASE_WS unsigned char* ws = GP(ws0); X.ws = ws; asm volatile("" : "+s"(X.G), "+s"(X.c), "+s"(X.vcu))
#define PHEN(j) (((PH_MASK) >> (j)) & 1)
#define IN(k) (lo <= (k) && (k) < hi)
#define SEAM(k) do { if ((k) + 1 < hi) xcd_barrier(bar, X.wave); } while (0)
    float* ss_mix = (float*)(ws0 + SS_MIX); float* ss_ffn = (float*)(ws0 + SS_FFN);
    float* ss_pg = (float*)(ws0 + SS_PG); float* ss_ple = (float*)(ws0 + SS_PLE);
    bf16* HB = (bf16*)(ws0 + WS_HB);
    const int NGT = X.G * 512;

    if (PHEN(10) && IN(0)) { prologue(X); SEAM(0); }

    for (int l = 0; l < DEPTH; ++l) {
        const int pb = 1 + 10 * l;
        if (PHEN(0) && IN(pb + 0)) { PHASE_WS;
            { int cc = X.c; asm volatile("" : "+s"(cc)); const int gt = cc * 512 + opaque_tid(X.wave);
              if (gt < 64) ((unsigned*)(ws + WS_CTL) + CW_CNT)[gt] = 0u; }
            int cin = X.c; asm volatile("" : "+s"(cin));
            pg8::InSched S; S.soA.init(M, 4 * 256, X.G, cin); S.soB.init(M, IN_W - 4 * 256, X.G, cin); S.split = (X.G == 256); S.A = (const char*)(ws + WS_HB); S.Bt = (const char*)(ws + WS_WIN) + (size_t)l * IN_W * D * 2; S.K = D;
            EpiIn E{ws, l};
            pg8::gemm_phase<EpiIn, pg8::InSched>(X.lds, D, S, E, X.wave);
            SEAM(pb + 0);
        }
        if (PHEN(1) && IN(pb + 1)) { PHASE_WS;
            attn_phase(X, l);
            hgrn_pass<false>(X, l);
            SEAM(pb + 1);
        }
        if (PHEN(2) && IN(pb + 2)) { PHASE_WS; hgrn_scan(X); SEAM(pb + 2); }
        if (PHEN(3) && IN(pb + 3)) { PHASE_WS; hgrn_pass<true>(X, l); SEAM(pb + 3); }
        if (PHEN(4) && IN(pb + 4)) { PHASE_WS;
            pg8::RegSched S; S.so.init(M, D, X.G, X.c); S.A = (const char*)(ws + WS_MIX); S.Bt = (const char*)(ws + WS_WOUT) + (size_t)l * D * D; S.K = D / 2;
            EpiResid E{ws};
            pg8::gemm_phase<EpiResid, pg8::RegSched>(X.lds, D / 2, S, E, X.wave);
            SEAM(pb + 4);
        }
        if (PHEN(5) && IN(pb + 5)) { PHASE_WS;
            router_phase(X, l);
            SEAM(pb + 5);
        }
#pragma unroll 1
        for (int mp = 0; mp < 3; ++mp) {
            if (!(PHEN(6 + mp) && IN(pb + 6 + mp))) continue;
            PHASE_WS;
            if (mp == 0 || !multi) moe_tables(X);
            const LAS int* PRE = (const LAS int*)(X.lds + LC_PRE); const LAS int* CNTL = (const LAS int*)(X.lds + LC_CNT);
            const int U6 = 4 * PRE[64], U7 = 4 * PRE[32], U8 = U6 - U7;
            if (mp == 0) {
                pg8::MoeSched<true> S; S.pre = PRE; S.cntl = CNTL; S.ubeg = 0; S.uend = U6; S.G = X.G; S.c = X.vcu; S.tokl = (const int*)(ws + WS_TOKL); S.A = (const char*)(ws + WS_HB2F8);
                S.W = (const char*)(ws + WS_WGU) + (size_t)l * NEXP * 1024 * D; S.K = D / 2; S.wstride = (size_t)1024 * D;
                EpiMoe1 E{ws, CNTL};
                pg8::gemm_phase<EpiMoe1, pg8::MoeSched<true>>(X.lds, D / 2, S, E, X.wave);
            } else {
                pg8::MoeSched<false> S; S.pre = PRE; S.cntl = CNTL; S.ubeg = (mp == 1) ? 0 : U7; S.uend = (mp == 1) ? U7 : U6; S.G = X.G; S.c = X.vcu; S.tokl = (const int*)(ws + WS_TOKL); S.A = (const char*)(ws + WS_HID);
                S.W = (const char*)(ws + WS_WD) + (size_t)l * NEXP * D * FF; S.K = FF / 2; S.wstride = (size_t)D * FF;
                EpiMoe2 E{ws, CNTL, mp == 2};
                pg8::gemm_phase<EpiMoe2, pg8::MoeSched<false>>(X.lds, FF / 2, S, E, X.wave);
            }
            {
                const int NPL = (M / 256) * (D / 256);
                const int r6 = U6 % X.G, r7 = U7 % X.G, r8 = U8 % X.G;
                const int t6 = (X.G - r6) < NPL ? (X.G - r6) : NPL, t7 = (X.G - r7) < (NPL - t6) ? (X.G - r7) : (NPL - t6), t8 = NPL - t6 - t7;
                pg8::TailSched T; T.G = X.G; T.c = X.vcu;
                T.nunits = (mp == 0) ? t6 : (mp == 1) ? t7 : t8; T.ubase = (mp == 0) ? 0 : (mp == 1) ? t6 : t6 + t7; T.nbig = (mp == 0) ? r6 : (mp == 1) ? r7 : r8;
                T.A = (const char*)(ws + WS_PB) + (size_t)l * M * PLE * 2; T.Bt = (const char*)(ws + WS_WPLE) + (size_t)l * D * PLE * 2; T.K = PLE;
                EpiPle1 E1{ws};
                pg8::gemm_phase<EpiPle1, pg8::TailSched>(X.lds, PLE, T, E1, X.wave);
            }
            SEAM(pb + 6 + mp);
        }
        if (PHEN(9) && IN(pb + 9)) { PHASE_WS;
            pg8::RegSched S; S.so.init(M, D, X.G, X.c); S.A = (const char*)(ws + WS_HB2); S.Bt = (const char*)(ws + WS_WPG) + (size_t)l * D * D * 2; S.K = D;
            EpiPle2 E{(l == DEPTH - 1) ? X.h : nullptr, ws, l};
            pg8::gemm_phase<EpiPle2, pg8::RegSched>(X.lds, D, S, E, X.wave);
            SEAM(pb + 9);
        }
    }
    if (multi && hi == 1 + 10 * DEPTH) {
        if (xb_ld((unsigned*)(ws0 + WS_CTL) + CW_BAR + XB_TMO) != 0u && opaque_tid(X.wave) == 0) X.h[(size_t)blockIdx.x * D] = __builtin_nanf("");
    }
#undef PHASE_WS
#undef IN
#undef SEAM
}

extern "C" void kernel_launch(void* const* d_in, const int* in_sizes, int n_in, void* d_out, int out_size, void* d_ws, size_t ws_size, hipStream_t stream) {
    static int grid = 0;
    if (grid == 0) {
        if (n_in != 21 || out_size != M * D || ws_size < WS_END) { fprintf(stderr, "kernel_launch: unexpected problem (n_in %d, out %d, ws %zu < %zu)\n", n_in, out_size, ws_size, (size_t)WS_END); grid = -1; return; }
        int dev = 0, cus = 0, per_cu = 0;
        if (hipGetDevice(&dev) != hipSuccess || hipDeviceGetAttribute(&cus, hipDeviceAttributeMultiprocessorCount, dev) != hipSuccess) { grid = -1; return; }
        if (hipFuncSetAttribute((const void*)hymba_fwd, hipFuncAttributeMaxDynamicSharedMemorySize, LDS_BYTES) != hipSuccess) { fprintf(stderr, "kernel_launch: hipFuncSetAttribute failed\n"); grid = -1; return; }
        if (hipOccupancyMaxActiveBlocksPerMultiprocessor(&per_cu, (const void*)hymba_fwd, 512, LDS_BYTES) != hipSuccess || per_cu < 1) { fprintf(stderr, "kernel_launch: occupancy query says %d\n", per_cu); per_cu = 1; }
        (void)hipGetLastError();
        grid = cus;
    }
    if (grid < 0) return;
    (void)hipMemsetAsync((char*)d_ws + WS_CTL, 0, CTL_ZERO_BYTES, stream);
    Args a{};
    for (int i = 0; i < 21; ++i) a.in[i] = (const float*)d_in[i];
    a.out = (float*)d_out; a.ws = (unsigned char*)d_ws;
#if ONE_LAUNCH
    a.ph_lo = 0; a.ph_hi = PH_HI;
    hipLaunchKernelGGL(hymba_fwd, dim3(grid), dim3(512), LDS_BYTES, stream, a);
#else
    for (int p = 0; p < PH_HI; ++p) { a.ph_lo = p; a.ph_hi = p + 1; hipLaunchKernelGGL(hymba_fwd, dim3(grid), dim3(512), LDS_BYTES, stream, a); }
#endif
}
```

```cpp
#include <hip/hip_runtime.h>
#include <cstdio>
#include <cstdint>

#ifndef ONE_LAUNCH
#define ONE_LAUNCH 1
#endif
#ifndef PH_HI
#define PH_HI 41

#endif

#define LAS __attribute__((address_space(3)))
typedef unsigned short bf16;
typedef short bf16x8 __attribute__((ext_vector_type(8)));
typedef short s16x4 __attribute__((ext_vector_type(4)));
typedef float f32x4 __attribute__((ext_vector_type(4)));
typedef float f32x16 __attribute__((ext_vector_type(16)));
typedef unsigned u32x4 __attribute__((ext_vector_type(4)));
typedef unsigned u32x2 __attribute__((ext_vector_type(2)));
typedef int v8i __attribute__((ext_vector_type(8)));
typedef short s16x16 __attribute__((ext_vector_type(16)));

constexpr int D = 1024, BATCH = 4, SEQ = 8192, DEPTH = 4, M = BATCH * SEQ;
constexpr int IN_W = 2816;
constexpr int NEXP = 32, FF = 512, PLE = 256;
constexpr int NGRP = 64;
constexpr float EPS = 1e-6f;

constexpr size_t MiB = 1u << 20;
constexpr size_t WS_CTL = 0, CTL_ZERO_BYTES = 1 * MiB;
constexpr float HID_SCALE = 4.f, WD_SCALE = 32.f;
constexpr float MIX_SCALE = 4.f, WOUT_SCALE = 32.f;
constexpr size_t WS_WIN = 1 * MiB, WS_WOUT = 23 * MiB, WS_WPLE = 31 * MiB, WS_WPG = 33 * MiB, WS_WR = 41 * MiB, WS_MISC = 42 * MiB;
constexpr size_t WS_WGU = 48 * MiB, WS_WD = 304 * MiB, WS_HB = 432 * MiB, WS_Q = 496 * MiB, WS_K = 528 * MiB, WS_V = 536 * MiB;
constexpr size_t WS_QR = 544 * MiB, WS_KEY = 576 * MiB, WS_IR = 608 * MiB, WS_GR = 640 * MiB, WS_LF = 672 * MiB, WS_MIX = 736 * MiB;
constexpr size_t WS_USUP = 800 * MiB, WS_PB = 832 * MiB, WS_TOKL = 896 * MiB, WS_WL = 904 * MiB, WS_HB2 = 912 * MiB, WS_SS = 976 * MiB, WS_CHS = 984 * MiB, WS_RSL = 988 * MiB  , WS_END = 996 * MiB;
constexpr size_t WS_HB2F8 = 176 * MiB;
constexpr size_t WS_HID = WS_QR;
constexpr size_t WS_PLERAW = WS_LF;
constexpr size_t SS_MIX = WS_SS, SS_FFN = WS_SS + 2 * MiB, SS_PG = WS_SS + 4 * MiB, SS_PLE = WS_SS + 6 * MiB;
constexpr size_t MISC_COS = 1 * MiB, MISC_SIN = 2 * MiB, MISC_LB = 3 * MiB, MISC_DSUP = 4 * MiB;
constexpr int CW_TMO = 0, CW_CNT = 1024, CW_BAR = 4096;

constexpr int STAGE_BYTES = 131072;
constexpr int LC_BASE = 133120;
constexpr int LC_PRE = LC_BASE, LC_CNT = LC_BASE + 320, LC_BAR = LC_BASE + 576;
constexpr int LDS_BYTES = LC_BASE + 2048;

__device__ __forceinline__ unsigned f2bf(float f) { unsigned u = __builtin_bit_cast(unsigned, f); return (u + 0x7fffu + ((u >> 16) & 1u)) >> 16; }
__device__ __forceinline__ unsigned pk2(float lo, float hi) { return f2bf(lo) | (f2bf(hi) << 16); }
__device__ __forceinline__ float bf2f(unsigned b) { return __builtin_bit_cast(float, b << 16); }
__device__ __forceinline__ unsigned cvt_pk_bf16(float lo, float hi) { unsigned r; asm volatile("v_cvt_pk_bf16_f32 %0, %1, %2" : "=v"(r) : "v"(lo), "v"(hi)); return r; }
__device__ __forceinline__ float fast_exp(float x) { return __builtin_amdgcn_exp2f(x * 1.4426950408889634f); }
__device__ __forceinline__ float silu(float x) { const float t = fast_exp(-x); return x * __builtin_amdgcn_rcpf(1.f + t); }
__device__ __forceinline__ float clamp_f8(float x) { float y; asm("v_max_f32 %0, 0xc3e00000, %1\n\tv_min_f32 %0, 0x43e00000, %0" : "=&v"(y) : "v"(x)); return y; }
__device__ __forceinline__ u32x2 pk_fp8x8(const f32x4& a, const f32x4& b) {
    int lo = __builtin_amdgcn_cvt_pk_fp8_f32(a[0], a[1], 0, false); lo = __builtin_amdgcn_cvt_pk_fp8_f32(a[2], a[3], lo, true);
    int hi = __builtin_amdgcn_cvt_pk_fp8_f32(b[0], b[1], 0, false); hi = __builtin_amdgcn_cvt_pk_fp8_f32(b[2], b[3], hi, true);
    u32x2 r; r.x = (unsigned)lo; r.y = (unsigned)hi; return r;
}
typedef _Float16 h16x2 __attribute__((ext_vector_type(2)));
#define MFMA16(a, b, c) __builtin_amdgcn_mfma_f32_16x16x32_bf16((a), (b), (c), 0, 0, 0)
#define MFMA32(a, b, c) __builtin_amdgcn_mfma_f32_32x32x16_bf16((a), (b), (c), 0, 0, 0)

#define GAS1 __attribute__((address_space(1)))
template <class T> __device__ __forceinline__ T* GP(T* p) { GAS1 T* g = (GAS1 T*)p; asm volatile("" : "+s"(g)); return (T*)g; }
__device__ __forceinline__ int lane_here() { int l; asm volatile("v_mbcnt_lo_u32_b32 %0, -1, 0\n\tv_mbcnt_hi_u32_b32 %0, -1, %0" : "=v"(l)); return l; }
__device__ __forceinline__ float shx(float v, int m) { return __builtin_bit_cast(float, __builtin_amdgcn_ds_bpermute((lane_here() ^ m) << 2, __builtin_bit_cast(int, v))); }
__device__ __forceinline__ float shl15(float v) { return __builtin_bit_cast(float, __builtin_amdgcn_ds_bpermute((lane_here() | 15) << 2, __builtin_bit_cast(int, v))); }
__device__ __forceinline__ const float* inp(int k) {
    unsigned long long kp = (unsigned long long)__builtin_amdgcn_kernarg_segment_ptr(); asm volatile("" : "+s"(kp));
    return (const float*)(GAS1 const float*)((const unsigned long long __attribute__((address_space(4)))*)kp)[k];
}

__device__ __forceinline__ int opaque_tid(int wave) {
    return wave * 64 + lane_here(); }

#define XB_TMO      128
#define XB_XCNT(j)  (256  + 64 * (j))
#define XB_XSUB(j)  (1280 + 64 * (j))
#define XB_XGEN(j)  (2304 + 64 * (j))
#define XB_TOP      3328
#define XB_TOPGEN   3392
#define XCD_BAR_WORDS 3456
#define XB_SPIN_CAP (1u << 18)
__device__ __forceinline__ unsigned xb_ld(unsigned* p)              { return __hip_atomic_load(p, __ATOMIC_RELAXED, __HIP_MEMORY_SCOPE_AGENT); }
__device__ __forceinline__ unsigned xb_add(unsigned* p, unsigned v) { return __hip_atomic_fetch_add(p, v, __ATOMIC_RELAXED, __HIP_MEMORY_SCOPE_AGENT); }
__device__ __forceinline__ unsigned xb_xcc_id() { return (unsigned)__builtin_amdgcn_s_getreg((3 << 11) | 20) & 0xFu; }
#define XB_SPIN(cond, bar) do { unsigned _sp = 0; while (cond) { __builtin_amdgcn_s_sleep(1); \
    if ((++_sp & 255u) == 0u) { if (xb_ld(&(bar)[XB_TMO])) break; if (_sp > XB_SPIN_CAP) { atomicAdd(&(bar)[XB_TMO], 1u); break; } } } } while (0)
struct XcdBarrier { unsigned* bar; unsigned x; volatile LAS unsigned* st; };
__device__ __forceinline__ XcdBarrier xcd_barrier_post(unsigned* bar, volatile LAS unsigned* st) {
    XcdBarrier b; b.bar = bar; b.x = xb_xcc_id(); b.st = st;
    if (threadIdx.x == 0) (void)xb_add(&bar[XB_XCNT(b.x)], 1u);
    return b;
}
__device__ __forceinline__ void xcd_barrier_complete(unsigned* bar, unsigned x, unsigned& nloc, unsigned& nx) {
    const unsigned G = gridDim.x * gridDim.y * gridDim.z;
    unsigned sum, cnt, mine, sp = 0u;
    for (;;) {
        sum = 0u; cnt = 0u; mine = 0u;
#pragma unroll
        for (unsigned j = 0; j < 16; ++j) { const unsigned c = xb_ld(&bar[XB_XCNT(j)]); sum += c; cnt += (c > 0u) ? 1u : 0u; mine = (j == x) ? c : mine; }
        if (sum == G) break;
        __builtin_amdgcn_s_sleep(1);
        if ((++sp & 255u) == 0u) { if (xb_ld(&bar[XB_TMO])) break; if (sp > XB_SPIN_CAP) { atomicAdd(&bar[XB_TMO], 1u); break; } }
    }
    nloc = mine > 0u ? mine : 1u; nx = cnt > 0u ? cnt : 1u;
}
__device__ __forceinline__ void xcd_barrier(const XcdBarrier& b, const int wave) {
    asm volatile("s_waitcnt vmcnt(0)" ::: "memory");
    __syncthreads();
    if (wave == 0 && lane_here() == 0) {
        unsigned* bar = GP(b.bar);
        __builtin_amdgcn_s_waitcnt(0);
        unsigned nloc = b.st[0], nx = b.st[1];
        if (nloc == 0u) { xcd_barrier_complete(bar, b.x, nloc, nx); b.st[0] = nloc; b.st[1] = nx; }
        const unsigned old = xb_add(&bar[XB_XSUB(b.x)], 1u);
        const unsigned gen = old / nloc;
        if (old + 1u == (gen + 1u) * nloc) {
            __builtin_amdgcn_fence(__ATOMIC_RELEASE, "agent");
            asm volatile("s_waitcnt vmcnt(0)" ::: "memory");
            const unsigned og = xb_add(&bar[XB_TOP], 1u);
            const unsigned tg = og / nx;
            if (og + 1u == (tg + 1u) * nx) xb_add(&bar[XB_TOPGEN], 1u);
            else XB_SPIN(xb_ld(&bar[XB_TOPGEN]) == tg, bar);
            __builtin_amdgcn_fence(__ATOMIC_ACQUIRE, "agent");
            xb_add(&bar[XB_XGEN(b.x)], 1u);
            asm volatile("s_waitcnt vmcnt(0)" ::: "memory");
        } else {
            XB_SPIN(xb_ld(&bar[XB_XGEN(b.x)]) == gen, bar);
            __builtin_amdgcn_fence(__ATOMIC_ACQUIRE, "agent");
            asm volatile("s_waitcnt vmcnt(0)" ::: "memory");
        }
    }
    __syncthreads();
}

namespace pg8 {
constexpr int BM = 256, BK = 64, HALF = 128, HTB = HALF * BK * 2, NXCD = 8, WGM = 8;
__device__ __forceinline__ int lds_byte(int r, int c) { const int st = (r >> 4) * 2 + (c >> 5), rr = r & 15, cc = c & 31, ob = rr * 64 + cc * 2; return st * 1024 + (ob ^ (((ob >> 9) & 1) << 5)); }
__device__ __forceinline__ void stage_rc(int b, int& R, int& C) { const int st = b / 1024, sb = b % 1024, swz = sb ^ (((sb >> 9) & 1) << 5); R = (st >> 1) * 16 + swz / 64; C = (st & 1) * 32 + (swz % 64) / 2; }
__device__ __forceinline__ int perm32(int rho) { const int n = rho >> 4, i = rho & 15; return 8 * (i >> 2) + 4 * n + (i & 3); }
struct Unit { int pm, pn, g, mt; };

struct StaticOrder {
    int nM, nN, nwg, G, c;
    __device__ void init(int M_, int N_, int G_, int c_) { nM = M_ / BM; nN = N_ / BM; nwg = nM * nN; G = G_; c = c_; }
    __device__ bool next(int i, Unit& u) const { return at((long)i * G + c, u); }
    __device__ bool at(long L, Unit& u) const {
        if (L >= nwg) return false;
        int wgid = (int)L; { const int q = nwg / NXCD, r = nwg % NXCD, xcd = wgid % NXCD, off = wgid / NXCD; wgid = (xcd < r ? xcd * (q + 1) : r * (q + 1) + (xcd - r) * q) + off; }
        const int nig = WGM * nN, gid = wgid / nig, fm = gid * WGM, gsz = (nM - fm) < WGM ? (nM - fm) : WGM;
        u.pm = fm + ((wgid % nig) % gsz); u.pn = (wgid % nig) / gsz; u.g = 0; u.mt = 0; return true;
    }
};
struct RegSched {
    static constexpr bool LANE_PER_UNIT = false;
    StaticOrder so; const char* A; const char* Bt; int K;
    __device__ __forceinline__ bool next(int i, Unit& u) const { return so.next(i, u); }
    __device__ __forceinline__ const char* a_ubase(const Unit& u) const { return A + (size_t)u.pm * BM * K * 2; }
    __device__ __forceinline__ size_t hstepA() const { return (size_t)HALF * K * 2; }
    __device__ __forceinline__ unsigned a_lane(const Unit&, int, int R, unsigned c2) const { return (unsigned)(R * K * 2) + c2; }
    __device__ __forceinline__ const char* b_base(const Unit& u) const { return Bt + (size_t)u.pn * BM * K * 2; }
};
struct InSched {
    static constexpr bool LANE_PER_UNIT = false;
    StaticOrder soA, soB; const char* A; const char* Bt; int K; bool split;
    __device__ __forceinline__ bool next(int i, Unit& u) const {
        bool ok;
        if (split) {
            const int c = soA.c, h = c >> 7, cl = c & 127, nA = h ? 3 : 1;
            if (i < nA) { ok = soA.at(h ? (long)i * 128 + cl : 384 + cl, u); u.pn = 3 + 2 * u.pn; return ok; }
            const int j = i - nA; if (j >= (h ? 2 : 5)) return false;
            ok = soB.at(h ? 640 + (long)j * 128 + cl : (long)j * 128 + cl, u);
        } else {
            if (i < 2) { ok = soA.next(i, u); u.pn = 3 + 2 * u.pn; return ok; }
            ok = soB.next(i - 2, u);
        }
        u.pn = (u.pn < 3) ? u.pn : 2 * u.pn - 2; return ok;
    }
    __device__ __forceinline__ const char* a_ubase(const Unit& u) const { return A + (size_t)u.pm * BM * K * 2; }
    __device__ __forceinline__ size_t hstepA() const { return (size_t)HALF * K * 2; }
    __device__ __forceinline__ unsigned a_lane(const Unit&, int, int R, unsigned c2) const { return (unsigned)(R * K * 2) + c2; }
    __device__ __forceinline__ const char* b_base(const Unit& u) const { return Bt + (size_t)u.pn * BM * K * 2; }
};
struct TailSched {
    static constexpr bool LANE_PER_UNIT = false;
    int nunits, nbig, G, c, ubase; const char* A; const char* Bt; int K;
    __device__ __forceinline__ bool next(int i, Unit& u) const {
        const int nt = G - nbig, ct = c - nbig; if (ct < 0) return false;
        int U = i * nt + ct; if (U >= nunits) return false;
        U += ubase; u.pm = U >> 2; u.pn = U & 3; u.g = 0; u.mt = 0; return true;
    }
    __device__ __forceinline__ const char* a_ubase(const Unit& u) const { return A + (size_t)u.pm * BM * K * 2; }
    __device__ __forceinline__ size_t hstepA() const { return (size_t)HALF * K * 2; }
    __device__ __forceinline__ unsigned a_lane(const Unit&, int, int R, unsigned c2) const { return (unsigned)(R * K * 2) + c2; }
    __device__ __forceinline__ const char* b_base(const Unit& u) const { return Bt + (size_t)u.pn * BM * K * 2; }
};
template <bool GATHER> struct MoeSched {
    static constexpr bool LANE_PER_UNIT = GATHER;

    const LAS int* pre; const LAS int* cntl; int ubeg, uend, G, c;
    const int* tokl; const char* A; const char* W; int K; size_t wstride;
    __device__ __forceinline__ bool next(int i, Unit& u) const {
        const int U = ubeg + i * G + c; if (U >= uend) return false;
        const int mg = U >> 2; const int lane = lane_here();
        const unsigned long long bal = __ballot(pre[lane] <= mg);
        const int g = __popcll(bal) - 1;
        u.pm = mg; u.pn = U & 3; u.g = g; u.mt = mg - pre[g]; return true;
    }
    __device__ __forceinline__ const char* a_ubase(const Unit& u) const { return GATHER ? A : A + (size_t)u.pm * BM * K * 2; }
    __device__ __forceinline__ size_t hstepA() const { return GATHER ? (size_t)0 : (size_t)HALF * K * 2; }
    __device__ __forceinline__ unsigned a_lane(const Unit& u, int h, int R, unsigned c2) const {
        if (GATHER) { const int cg = cntl[u.g]; const int rg = u.mt * BM + h * HALF + R; const int tok = tokl[(size_t)u.g * M + (rg < cg ? rg : 0)]; return (unsigned)tok * (unsigned)(K * 2) + c2; }
        return (unsigned)(R * K * 2) + c2;
    }
    __device__ __forceinline__ const char* b_base(const Unit& u) const { return W + (size_t)(u.g & 31) * wstride + (size_t)u.pn * BM * K * 2; }
};

template <class Epi, class Sched>
__device__ __forceinline__ void gemm_phase(LAS unsigned char* lds, const int Kc, const Sched& S, const Epi& E, const int wave0) {
    int K = Kc; asm volatile("" : "+s"(K));
    const int tid = opaque_tid(wave0), wid = __builtin_amdgcn_readfirstlane(tid >> 6), lane = tid & 63, wr = wid >> 2, wc = wid & 3, fr = lane & 15, fq = lane >> 4;
    const int nt = K / BK;
    unsigned voffB[2];
#pragma unroll
    for (int i = 0; i < 2; ++i) { int R, C; stage_rc(tid * 16 + i * 8192, R, C); const int Rb = Epi::PERM ? ((R & ~31) + perm32(R & 31)) : R;
        voffB[i] = (unsigned)(Rb * K + C) * 2u; }
#define PG8_ALANE(dst, unit) do { const int _t = opaque_tid(wave0); _Pragma("unroll") for (int _i = 0; _i < 2; ++_i) { int _R, _C; stage_rc(_t * 16 + _i * 8192, _R, _C); \
        _Pragma("unroll") for (int _h = 0; _h < 2; ++_h) dst[_h][_i] = S.a_lane(unit, _h, _R, (unsigned)_C * 2u); } } while (0)
    const size_t kstep = (size_t)(BK * 2);
    const size_t hstepB = (size_t)HALF * K * 2;
    const unsigned ldsw = (unsigned)wid * 1024u;
    const int aoff = lds_byte(wr * 64 + fr, fq * 8), boff = lds_byte(wc * 32 + fr, fq * 8);
#define PG8_SA(b, h) (((b) * 2 + (h)) * HTB)
#define PG8_SB(b, h) ((4 + (b) * 2 + (h)) * HTB)
#define PG8_STAGE_B(bufoff, gbase) do { _Pragma("unroll") for (int _i = 0; _i < 2; ++_i) { unsigned _o = voffB[_i]; asm volatile("" : "+v"(_o)); \
        __builtin_amdgcn_global_load_lds((const unsigned*)((const char*)(gbase) + _o), (LAS unsigned*)(lds + (bufoff) + ldsw + _i * 8192), 16, 0, 0); } } while (0)
#define PG8_STAGE_A(bufoff, gbase, offs) do { _Pragma("unroll") for (int _i = 0; _i < 2; ++_i) { unsigned _o = (offs)[_i]; asm volatile("" : "+v"(_o)); \
        __builtin_amdgcn_global_load_lds((const unsigned*)((const char*)(gbase) + _o), (LAS unsigned*)(lds + (bufoff) + ldsw + _i * 8192), 16, 0, 0); } } while (0)
#define PG8_LDA(dst, b, h) do { _Pragma("unroll") for (int m = 0; m < 4; ++m) { const bf16x8 _l = *(const LAS bf16x8*)(lds + PG8_SA(b, h) + aoff + m * 2048), _h = *(const LAS bf16x8*)(lds + PG8_SA(b, h) + aoff + m * 2048 + 1024); \
        dst[m] = __builtin_shufflevector(_l, _h, 0, 1, 2, 3, 4, 5, 6, 7, 8, 9, 10, 11, 12, 13, 14, 15); } } while (0)
#define PG8_LDB(dst, b, h) do { _Pragma("unroll") for (int n = 0; n < 2; ++n) { const bf16x8 _l = *(const LAS bf16x8*)(lds + PG8_SB(b, h) + boff + n * 2048), _h = *(const LAS bf16x8*)(lds + PG8_SB(b, h) + boff + n * 2048 + 1024); \
        dst[n] = __builtin_shufflevector(_l, _h, 0, 1, 2, 3, 4, 5, 6, 7, 8, 9, 10, 11, 12, 13, 14, 15); } } while (0)
#define PG8_LO(v) __builtin_shufflevector(v, v, 0, 1, 2, 3, 4, 5, 6, 7)
#define PG8_HI(v) __builtin_shufflevector(v, v, 8, 9, 10, 11, 12, 13, 14, 15)
#define PG8_MMA(ai, bj, At, Bt) do { __builtin_amdgcn_s_setprio(1); _Pragma("unroll") for (int m = 0; m < 4; ++m) _Pragma("unroll") for (int n = 0; n < 2; ++n) { \
        acc[ai][bj][m][n] = __builtin_amdgcn_mfma_f32_16x16x32_bf16(PG8_LO(Bt[n]), PG8_LO(At[m]), acc[ai][bj][m][n], 0, 0, 0); \
        acc[ai][bj][m][n] = __builtin_amdgcn_mfma_f32_16x16x32_bf16(PG8_HI(Bt[n]), PG8_HI(At[m]), acc[ai][bj][m][n], 0, 0, 0); } __builtin_amdgcn_s_setprio(0); } while (0)
#define PG8_MMA8(ai, bj, At, Bt) do { __builtin_amdgcn_s_setprio(1); _Pragma("unroll") for (int m = 0; m < 4; ++m) _Pragma("unroll") for (int n = 0; n < 2; ++n) { \
        acc[ai][bj][m][n] = __builtin_amdgcn_mfma_scale_f32_16x16x128_f8f6f4(__builtin_bit_cast(v8i, Bt[n]), __builtin_bit_cast(v8i, At[m]), acc[ai][bj][m][n], 0, 0, 0, 0x7f7f7f7f, 0, 0x7f7f7f7f); } __builtin_amdgcn_s_setprio(0); } while (0)
#define PG8_MM(ai, bj, At, Bt) do { if constexpr (Epi::F8) PG8_MMA8(ai, bj, At, Bt); else PG8_MMA(ai, bj, At, Bt); } while (0)
#define PG8_WAIT_V(n) asm volatile("s_waitcnt vmcnt(" #n ")" ::: "memory")
#define PG8_WAIT_V8_UNLESS(f) asm volatile("s_cmp_lg_u32 %0, 0\n\ts_cbranch_scc1 1f\n\ts_waitcnt vmcnt(8)\n1:" :: "s"(f) : "memory", "scc")
#define PG8_WAIT_L(n) asm volatile("s_waitcnt lgkmcnt(" #n ")" ::: "memory")
#define PG8_BAR __builtin_amdgcn_s_barrier()
#define PG8_SCHED __builtin_amdgcn_sched_barrier(0)
    Unit cur, nxt; int ui = 0;
    if (!S.next(0, cur)) return;
    const size_t hstepA = S.hstepA();
    unsigned coff[2][2], noff[2][2];
    PG8_ALANE(coff, cur);
    const char* cA = S.a_ubase(cur);
    const char* cB = S.b_base(cur);
    f32x4 acc[2][2][4][2];
#pragma unroll
    for (int a = 0; a < 2; ++a)
#pragma unroll
        for (int b = 0; b < 2; ++b)
#pragma unroll
            for (int m = 0; m < 4; ++m)
#pragma unroll
                for (int n = 0; n < 2; ++n) acc[a][b][m][n] = (f32x4){0.f, 0.f, 0.f, 0.f};
    s16x16 At[4], B0[2], B1[2];
    PG8_STAGE_B(PG8_SB(0, 0), cB); PG8_STAGE_B(PG8_SB(0, 1), cB + hstepB); PG8_STAGE_A(PG8_SA(0, 0), cA, coff[0]); PG8_STAGE_A(PG8_SA(0, 1), cA + hstepA, coff[1]);
    if (wr == 1) PG8_BAR;
    PG8_WAIT_V(2); PG8_BAR;
    PG8_STAGE_B(PG8_SB(1, 0), cB + kstep); PG8_STAGE_A(PG8_SA(1, 0), cA + kstep, coff[0]); PG8_STAGE_B(PG8_SB(1, 1), cB + hstepB + kstep);
    PG8_WAIT_V(6); PG8_BAR;
    int fast1 = 0;
    for (;;) {
        const bool has_next = S.next(ui + 1, nxt);
        const char* nB = cB; const char* nA = cA;
        if (has_next) {
            if constexpr (Sched::LANE_PER_UNIT) PG8_ALANE(noff, nxt);
            nB = S.b_base(nxt); nA = S.a_ubase(nxt);
        } else if constexpr (Sched::LANE_PER_UNIT) {
#pragma unroll
            for (int h = 0; h < 2; ++h)
#pragma unroll
                for (int i = 0; i < 2; ++i) noff[h][i] = coff[h][i];
        }
        int fz = fast1;
        for (int t = 0; t < nt; t += 2) {
            const bool last = (t == nt - 2); const int f1 = fz; fz = 0; asm volatile("" : "+s"(fz));
            const char* a1 = cA + (size_t)(t + 1) * kstep;
            const char* a2 = last ? nA : cA + (size_t)(t + 2) * kstep;
            const char* b2 = last ? nB : cB + (size_t)(t + 2) * kstep;
            const char* a3 = a2 + kstep; const char* b3 = b2 + kstep;
            PG8_LDB(B0, 0, 0); PG8_LDB(B1, 0, 1); PG8_SCHED; PG8_LDA(At, 0, 0); PG8_STAGE_A(PG8_SA(1, 1), a1 + hstepA, coff[1]);
            PG8_WAIT_V8_UNLESS(f1); PG8_WAIT_L(0); PG8_BAR; PG8_MM(0, 0, At, B0); PG8_MM(0, 1, At, B1); PG8_BAR; PG8_SCHED;
            if (Sched::LANE_PER_UNIT && last) {
#pragma unroll
                for (int h = 0; h < 2; ++h)
#pragma unroll
                    for (int i = 0; i < 2; ++i) coff[h][i] = noff[h][i];
            }
            PG8_LDA(At, 0, 1); PG8_STAGE_B(PG8_SB(0, 0), b2); PG8_STAGE_B(PG8_SB(0, 1), b2 + hstepB); PG8_STAGE_A(PG8_SA(0, 0), a2, coff[0]);
            PG8_WAIT_V8_UNLESS(f1); PG8_WAIT_L(0); PG8_BAR; PG8_MM(1, 0, At, B0); PG8_MM(1, 1, At, B1); PG8_BAR; PG8_SCHED;
            PG8_LDB(B0, 1, 0); PG8_LDB(B1, 1, 1); PG8_SCHED; PG8_LDA(At, 1, 0); PG8_STAGE_A(PG8_SA(0, 1), a2 + hstepA, coff[1]);
            PG8_WAIT_V8_UNLESS(f1); PG8_WAIT_L(0); PG8_BAR; PG8_MM(0, 0, At, B0); PG8_MM(0, 1, At, B1); PG8_BAR; PG8_SCHED;
            PG8_LDA(At, 1, 1); PG8_STAGE_B(PG8_SB(1, 0), b3); PG8_STAGE_B(PG8_SB(1, 1), b3 + hstepB); PG8_STAGE_A(PG8_SA(1, 0), a3, coff[0]);
            PG8_WAIT_V(8); PG8_WAIT_L(0); PG8_BAR; PG8_MM(1, 0, At, B0); PG8_MM(1, 1, At, B1); PG8_BAR; PG8_SCHED;
        }
        if (wr == 0) PG8_BAR;
        if (has_next) PG8_STAGE_A(PG8_SA(1, 1), nA + kstep + hstepA, coff[1]);
#ifdef STUB_EPI
        if (cur.pm == 12345) E(acc, cur, wr, wc, fr, fq); else { float q = 0.f; _Pragma("unroll") for (int a = 0; a < 2; ++a) _Pragma("unroll") for (int b = 0; b < 2; ++b) _Pragma("unroll") for (int m = 0; m < 4; ++m) _Pragma("unroll") for (int n = 0; n < 2; ++n) q += acc[a][b][m][n][0] + acc[a][b][m][n][1] + acc[a][b][m][n][2] + acc[a][b][m][n][3]; if (q == 1.2345f) ((float*)lds)[0] = q; }
#else
        { const int le = lane_here(); E(acc, cur, wr, wc, le & 15, le >> 4); }
#endif
        if (!has_next) break;
#pragma unroll
        for (int a = 0; a < 2; ++a)
#pragma unroll
            for (int b = 0; b < 2; ++b)
#pragma unroll
                for (int m = 0; m < 4; ++m)
#pragma unroll
                    for (int n = 0; n < 2; ++n) acc[a][b][m][n] = (f32x4){0.f, 0.f, 0.f, 0.f};
        cur = nxt; cB = nB; cA = nA; ++ui; fast1 = 1;
        if (wr == 1) PG8_BAR;
    }
    PG8_WAIT_V(0);
    PG8_BAR;
#undef PG8_ALANE
#undef PG8_SA
#undef PG8_SB
#undef PG8_STAGE_A
#undef PG8_STAGE_B
#undef PG8_LDA
#undef PG8_LDB
#undef PG8_LO
#undef PG8_HI
#undef PG8_MMA
#undef PG8_MMA8
#undef PG8_MM
#undef PG8_WAIT_V
#undef PG8_WAIT_L
#undef PG8_WAIT_V8_UNLESS
#undef PG8_BAR
#undef PG8_SCHED
}
}
using pg8::Unit;

__device__ __forceinline__ void up_bf16x8(const u32x4& w, f32x4& a, f32x4& b) {
    a = (f32x4){__builtin_bit_cast(float, w.x << 16), __builtin_bit_cast(float, w.x & 0xffff0000u), __builtin_bit_cast(float, w.y << 16), __builtin_bit_cast(float, w.y & 0xffff0000u)};
    b = (f32x4){__builtin_bit_cast(float, w.z << 16), __builtin_bit_cast(float, w.z & 0xffff0000u), __builtin_bit_cast(float, w.w << 16), __builtin_bit_cast(float, w.w & 0xffff0000u)};
}
__device__ __forceinline__ void ld_bf16x8(const bf16* p, f32x4& a, f32x4& b) {
    const u32x4 w = *(const u32x4*)p;
    a = (f32x4){__builtin_bit_cast(float, w.x << 16), __builtin_bit_cast(float, w.x & 0xffff0000u), __builtin_bit_cast(float, w.y << 16), __builtin_bit_cast(float, w.y & 0xffff0000u)};
    b = (f32x4){__builtin_bit_cast(float, w.z << 16), __builtin_bit_cast(float, w.z & 0xffff0000u), __builtin_bit_cast(float, w.w << 16), __builtin_bit_cast(float, w.w & 0xffff0000u)};
}
__device__ __forceinline__ void st_bf16x8(bf16* p, const f32x4& a, const f32x4& b) {
    u32x4 w; w.x = cvt_pk_bf16(a[0], a[1]); w.y = cvt_pk_bf16(a[2], a[3]); w.z = cvt_pk_bf16(b[0], b[1]); w.w = cvt_pk_bf16(b[2], b[3]);
    *(u32x4*)p = w;
}
__device__ __forceinline__ void st_bf16x4(bf16* p, const f32x4& a) { u32x2 w; w.x = cvt_pk_bf16(a[0], a[1]); w.y = cvt_pk_bf16(a[2], a[3]); *(u32x2*)p = w; }
__device__ __forceinline__ float sq8(const f32x4& a, const f32x4& b) { const f32x4 qa = a * a, qb = b * b; return ((qa[0] + qa[1]) + (qa[2] + qa[3])) + ((qb[0] + qb[1]) + (qb[2] + qb[3])); }
__device__ __forceinline__ float ss_row(const float* ss, int row) {
    const f32x4* p = (const f32x4*)(ss + (size_t)row * 16); const f32x4 a = p[0], b = p[1], c = p[2], d = p[3];
    return (((a[0] + a[1]) + (a[2] + a[3])) + ((b[0] + b[1]) + (b[2] + b[3]))) + (((c[0] + c[1]) + (c[2] + c[3])) + ((d[0] + d[1]) + (d[2] + d[3])));
}
__device__ __forceinline__ float ss_row4(const float* ss, int row, int fq) {
    const f32x4 a = *(const f32x4*)(ss + (size_t)row * 16 + 4 * fq); float s = (a[0] + a[1]) + (a[2] + a[3]);
    s += shx(s, 16); s += shx(s, 32); return s;
}
template <class T> __device__ __forceinline__ T ldo(const void* base, unsigned off) { return *(const T*)((const char*)base + off); }
template <class T> __device__ __forceinline__ void sto(void* base, unsigned off, const T& v) { *(T*)((char*)base + off) = v; }
__device__ __forceinline__ void sto_bf16x8(void* base, unsigned off, const f32x4& a, const f32x4& b) {
    u32x4 w; w.x = cvt_pk_bf16(a[0], a[1]); w.y = cvt_pk_bf16(a[2], a[3]); w.z = cvt_pk_bf16(b[0], b[1]); w.w = cvt_pk_bf16(b[2], b[3]); sto<u32x4>(base, off, w);
}
#define PIN1(x) asm volatile("" : "+v"(x))
#define PIN4(x) asm volatile("" : "+v"(x))
#define EPI_LOADS_DONE() do { asm volatile("s_waitcnt vmcnt(0)" ::: "memory"); __builtin_amdgcn_sched_barrier(0); } while (0)
#define EPI_FENCE() do { asm volatile("" ::: "memory"); __builtin_amdgcn_sched_barrier(0); } while (0)
__device__ __forceinline__ void rs_rows8(const float* ss, int rowb, int fq, float (&rs)[2][4], float post = 1.f) {
    const unsigned ob = (unsigned)rowb * 64u + 16u * (unsigned)fq; f32x4 a[2][4]; const int lh = lane_here(), x16 = (lh ^ 16) << 2, x32 = (lh ^ 32) << 2;
#pragma unroll
    for (int ai = 0; ai < 2; ++ai)
#pragma unroll
        for (int m = 0; m < 4; ++m) a[ai][m] = ldo<f32x4>(ss, ob + (unsigned)(ai * 128 + m * 16) * 64u);
#pragma unroll
    for (int ai = 0; ai < 2; ++ai)
#pragma unroll
        for (int m = 0; m < 4; ++m) { float q = (a[ai][m][0] + a[ai][m][1]) + (a[ai][m][2] + a[ai][m][3]);
            q += __builtin_bit_cast(float, __builtin_amdgcn_ds_bpermute(x16, __builtin_bit_cast(int, q))); q += __builtin_bit_cast(float, __builtin_amdgcn_ds_bpermute(x32, __builtin_bit_cast(int, q)));
            rs[ai][m] = rsqrtf(q + EPS * D) * (32.f * post); PIN1(rs[ai][m]); }
}
#define SS_STORE8(base, rowb_, slot_, v8) do { _Pragma("unroll") for (int _h = 0; _h < 2; ++_h) { const float _v = (fq == 0) ? (v8)[_h][0] : (fq == 1) ? (v8)[_h][1] : (fq == 2) ? (v8)[_h][2] : (v8)[_h][3]; \
        sto<float>((base), (((unsigned)(rowb_) + (unsigned)(_h * 128) + 16u * (unsigned)fq) * 16u + (unsigned)(slot_)) * 4u, _v); } } while (0)
#define ROWS8 _Pragma("unroll") for (int ai = 0; ai < 2; ++ai) _Pragma("unroll") for (int m = 0; m < 4; ++m)
#define RO(ai, m) ((unsigned)((ai) * 128 + (m) * 16))

struct EpiIn {
    static constexpr bool PERM = true, F8 = false;
    unsigned char* ws0; int l;
    __device__ __forceinline__ void operator()(f32x4 (&acc)[2][2][4][2], const Unit& u, int wr, int wc, int fr, int fq) const {
        unsigned char* ws = ws0; ws = GP(ws);
        const float* ss = (const float*)(ws + SS_MIX);
        const int pn = u.pn, rowb = u.pm * 256 + wr * 64 + fr;
        if (pn <= 2) {
            if (pn == 2 && wc >= 2) {
                float rs8[2][4]; rs_rows8(ss, rowb, fq, rs8); EPI_FENCE(); EPI_LOADS_DONE();
                const unsigned ob = (unsigned)rowb * 256u + (unsigned)((wc - 2) * 64 + 8 * fq) * 2u;
                ROWS8 {
#pragma unroll
                    for (int bj = 0; bj < 2; ++bj) sto_bf16x8(ws + WS_V, ob + RO(ai, m) * 256u + 64u * bj, acc[ai][bj][m][0] * rs8[ai][m], acc[ai][bj][m][1] * rs8[ai][m]); }
            } else {
                const float* gn = ((pn == 2) ? inp(6) : inp(5)) + l * 64; const float sc = (pn == 2) ? 1.f : 0.125f;
                const unsigned char* csT = ws + WS_MISC + MISC_COS;
                unsigned gh[2][2][2];
#pragma unroll
                for (int bj = 0; bj < 2; ++bj)
#pragma unroll
                    for (int n = 0; n < 2; ++n) { const f32x4 g = ldo<f32x4>(gn, (unsigned)(32 * bj + 8 * fq + 4 * n) * 4u);
#pragma unroll
                        for (int k = 0; k < 2; ++k) { h16x2 pr; pr[0] = (_Float16)g[2 * k]; pr[1] = (_Float16)g[2 * k + 1]; gh[bj][n][k] = __builtin_bit_cast(unsigned, pr); PIN1(gh[bj][n][k]); } }
                u32x4 pk[2][4][2];
                ROWS8 { f32x4 v[2][2]; u32x4 cs4[2]; float s2 = 0.f; float rs;
                    { const f32x4 a = ldo<f32x4>(ss, ((unsigned)rowb + RO(ai, m)) * 64u + 16u * (unsigned)fq); float q = (a[0] + a[1]) + (a[2] + a[3]); q += shx(q, 16); q += shx(q, 32); rs = rsqrtf(q + EPS * D) * 32.f; }
#pragma unroll
                    for (int n = 0; n < 2; ++n) cs4[n] = ldo<u32x4>(csT, ((unsigned)rowb + RO(ai, m)) * 32u + 16u * n);
#pragma unroll
                    for (int bj = 0; bj < 2; ++bj)
#pragma unroll
                        for (int n = 0; n < 2; ++n) { v[bj][n] = acc[ai][bj][m][n] * rs; const f32x4 q = v[bj][n] * v[bj][n]; s2 += (q[0] + q[1]) + (q[2] + q[3]); }
                    s2 += shx(s2, 16); s2 += shx(s2, 32);
                    const float hr = rsqrtf(s2 + EPS * 64.f) * (8.f * sc);
#pragma unroll
                    for (int bj = 0; bj < 2; ++bj)
#pragma unroll
                        for (int n = 0; n < 2; ++n) {
#pragma unroll
                            for (int k = 0; k < 2; ++k) { unsigned gw = gh[bj][n][k]; PIN1(gw); const h16x2 pr = __builtin_bit_cast(h16x2, gw);
                                v[bj][n][2 * k] = v[bj][n][2 * k] * hr * (float)pr[0]; v[bj][n][2 * k + 1] = v[bj][n][2 * k + 1] * hr * (float)pr[1]; } }
#pragma unroll
                    for (int n = 0; n < 2; ++n) {
#pragma unroll
                        for (int i = 0; i < 4; ++i) { const float x = v[0][n][i]; const float o = shx(x, 16); const unsigned cw = cs4[n][i]; const h16x2 pr = __builtin_bit_cast(h16x2, cw); const float cv = (float)pr[0], sv = (float)pr[1];
                            const float r0 = x * cv - o * sv, r1 = x * cv + o * sv;
                            v[0][n][i] = (fq == 0) ? r0 : ((fq == 1) ? r1 : x); } }
#pragma unroll
                    for (int bj = 0; bj < 2; ++bj) { u32x4 w; w.x = cvt_pk_bf16(v[bj][0][0], v[bj][0][1]); w.y = cvt_pk_bf16(v[bj][0][2], v[bj][0][3]); w.z = cvt_pk_bf16(v[bj][1][0], v[bj][1][1]); w.w = cvt_pk_bf16(v[bj][1][2], v[bj][1][3]);
                        PIN4(w); pk[ai][m][bj] = w; }
                    }
                EPI_FENCE(); EPI_LOADS_DONE();
                unsigned char* dst = (pn == 2) ? (ws + WS_K) : (ws + WS_Q); const unsigned pitch = (pn == 2) ? 256u : 1024u;
                const unsigned ob = (unsigned)rowb * pitch + (unsigned)(((pn == 2) ? wc : (4 * pn + wc)) * 64 + 8 * fq) * 2u;
                ROWS8 {
#pragma unroll
                    for (int bj = 0; bj < 2; ++bj) sto<u32x4>(dst, ob + RO(ai, m) * pitch + 64u * bj, pk[ai][m][bj]); }
            }
        } else {
            const int hd = (pn - 3) >> 1;
            const int cb0 = hd * 128 + 32 * wc + 8 * fq;
            const unsigned ob = (unsigned)rowb * 1024u + (unsigned)cb0 * 2u;
            float rs8[2][4]; rs_rows8(ss, rowb, fq, rs8);
            if (((pn - 3) & 1) == 0) {
                const float* lb = (const float*)(ws + WS_MISC + MISC_LB) + l * 512;
                const f32x4 lbv4[2] = {ldo<f32x4>(lb, (unsigned)cb0 * 4u), ldo<f32x4>(lb, (unsigned)cb0 * 4u + 16u)};
                EPI_FENCE(); EPI_LOADS_DONE();
#pragma unroll
                for (int ai = 0; ai < 2; ++ai) {
                    float chv[8];
                    unsigned qp[4][4], kp[4][4];
#pragma unroll
                    for (int n = 0; n < 2; ++n)
#pragma unroll
                        for (int ip = 0; ip < 2; ++ip) {
                            const int dcol = cb0 + 4 * n + 2 * ip; const float lb0 = lbv4[n][2 * ip], lb1 = lbv4[n][2 * ip + 1];
                            float qh[4][2], kh[4][2], ebr[2], ecc[2], edc[2];
#pragma unroll
                            for (int e = 0; e < 2; ++e) { const int i = 2 * ip + e; const float lbv = e ? lb1 : lb0;
                                float key[4], p[4], tot[4];
#pragma unroll
                                for (int m = 0; m < 4; ++m) { const float z = acc[ai][1][m][n][i] * rs8[ai][m]; const float t = fast_exp(-fmaxf(z, -30.f)), sg = __builtin_amdgcn_rcpf(1.f + t);
                                    key[m] = (1.f - lbv) * (t * sg); float v = __builtin_amdgcn_logf(lbv + (1.f - lbv) * sg) * 0.69314718f;
                                    v += __builtin_bit_cast(float, __builtin_amdgcn_update_dpp(0, __builtin_bit_cast(int, v), 0x111, 0xf, 0xf, true));
                                    v += __builtin_bit_cast(float, __builtin_amdgcn_update_dpp(0, __builtin_bit_cast(int, v), 0x112, 0xf, 0xf, true));
                                    v += __builtin_bit_cast(float, __builtin_amdgcn_update_dpp(0, __builtin_bit_cast(int, v), 0x114, 0xf, 0xf, true));
                                    v += __builtin_bit_cast(float, __builtin_amdgcn_update_dpp(0, __builtin_bit_cast(int, v), 0x118, 0xf, 0xf, true));
                                    p[m] = v; tot[m] = __builtin_bit_cast(float, __builtin_amdgcn_update_dpp(0, __builtin_bit_cast(int, v), 0x15F, 0xf, 0xf, false)); }
                                const float o1 = tot[0], o2 = o1 + tot[1], o3 = o2 + tot[2], blast = o3 + tot[3], bref = o2;
                                const float bb[4] = {p[0], p[1] + o1, p[2] + o2, p[3] + o3};
#pragma unroll
                                for (int m = 0; m < 4; ++m) { const float q = silu(acc[ai][0][m][n][i] * rs8[ai][m]);
                                    qh[m][e] = q * fast_exp(fminf(bb[m] - bref, 80.f)); kh[m][e] = key[m] * fast_exp(fminf(bref - bb[m], 80.f)); }
                                ebr[e] = fast_exp(bref); ecc[e] = fast_exp(blast - bref); edc[e] = fast_exp(blast); }
#pragma unroll
                            for (int m = 0; m < 4; ++m) { qp[m][2 * n + ip] = cvt_pk_bf16(qh[m][0], qh[m][1]); kp[m][2 * n + ip] = cvt_pk_bf16(kh[m][0], kh[m][1]); }
#pragma unroll
                            for (int e = 0; e < 2; ++e) chv[4 * n + 2 * ip + e] = (fr == 0) ? ebr[e] : ((fr == 1) ? ecc[e] : edc[e]);
                            EPI_FENCE();
                        }
                    if (fr < 3) { const unsigned co = (unsigned)((u.pm * 4 + ai * 2 + wr) * 512 + cb0) * 4u + (unsigned)fr * ((unsigned)(M / 64) * 2048u);
                        sto<f32x4>(ws + WS_CHS, co, (f32x4){chv[0], chv[1], chv[2], chv[3]}); sto<f32x4>(ws + WS_CHS, co + 16u, (f32x4){chv[4], chv[5], chv[6], chv[7]}); }
#pragma unroll
                    for (int m = 0; m < 4; ++m) { const unsigned go = ob + RO(ai, m) * 1024u;
                        sto<u32x4>(ws + WS_QR, go, (u32x4){qp[m][0], qp[m][1], qp[m][2], qp[m][3]}); sto<u32x4>(ws + WS_KEY, go, (u32x4){kp[m][0], kp[m][1], kp[m][2], kp[m][3]}); }
                }
            } else {
                EPI_FENCE(); EPI_LOADS_DONE();
                ROWS8 { const float rs = rs8[ai][m];
                    f32x4 a = acc[ai][1][m][0] * rs, b = acc[ai][1][m][1] * rs;
#pragma unroll
                    for (int i = 0; i < 4; ++i) { a[i] = silu(a[i]); b[i] = silu(b[i]); }
                    sto_bf16x8(ws + WS_IR, ob + RO(ai, m) * 1024u, acc[ai][0][m][0] * rs, acc[ai][0][m][1] * rs);
                    sto_bf16x8(ws + WS_GR, ob + RO(ai, m) * 1024u, a, b); }
            }
        }
    }
};

struct EpiResid {
    static constexpr bool PERM = true, F8 = true;
    unsigned char* ws0;
    __device__ __forceinline__ void operator()(f32x4 (&acc)[2][2][4][2], const Unit& u, int wr, int wc, int fr, int fq) const {
        unsigned char* ws = ws0; ws = GP(ws);
        const int rowb = u.pm * 256 + wr * 64 + fr, col0 = u.pn * 256 + wc * 64 + 8 * fq;
        const unsigned ob = ((unsigned)rowb * D + (unsigned)col0) * 2u;
#pragma unroll
        for (int ai = 0; ai < 2; ++ai) { u32x4 r[4][2];
#pragma unroll
            for (int m = 0; m < 4; ++m)
#pragma unroll
                for (int bj = 0; bj < 2; ++bj) r[m][bj] = ldo<u32x4>(ws + WS_HB, ob + RO(ai, m) * (D * 2u) + 64u * bj);
#pragma unroll
            for (int m = 0; m < 4; ++m)
#pragma unroll
                for (int bj = 0; bj < 2; ++bj) { f32x4 ra, rb; up_bf16x8(r[m][bj], ra, rb); acc[ai][bj][m][0] = acc[ai][bj][m][0] * (1.f / (MIX_SCALE * WOUT_SCALE)) + ra; acc[ai][bj][m][1] = acc[ai][bj][m][1] * (1.f / (MIX_SCALE * WOUT_SCALE)) + rb; PIN4(acc[ai][bj][m][0]); PIN4(acc[ai][bj][m][1]); } }
        EPI_FENCE(); EPI_LOADS_DONE();
        float ss8[2][4];
        ROWS8 { float s2 = 0.f; u32x2 f8[2];
#pragma unroll
            for (int bj = 0; bj < 2; ++bj) { const unsigned o = ob + RO(ai, m) * (D * 2u) + 64u * bj;
                const f32x4 va = acc[ai][bj][m][0], vb = acc[ai][bj][m][1]; sto_bf16x8(ws + WS_HB2, o, va, vb); f8[bj] = pk_fp8x8(va, vb); s2 += sq8(va, vb); }
            asm volatile("s_nop 3\n\tv_permlane16_swap_b32 %0, %2\n\ts_nop 1\n\tv_permlane16_swap_b32 %1, %3\n\ts_nop 3" : "+v"(f8[0].x), "+v"(f8[0].y), "+v"(f8[1].x), "+v"(f8[1].y));
            sto<u32x4>(ws + WS_HB2F8, ((ob + RO(ai, m) * (D * 2u)) >> 1) + ((fq & 1) ? 24u : 0u), (u32x4){f8[0].x, f8[0].y, f8[1].x, f8[1].y});
            s2 += shx(s2, 16); s2 += shx(s2, 32); ss8[ai][m] = s2; }
        SS_STORE8(ws + SS_FFN, rowb, u.pn * 4 + wc, ss8);
    }
};
struct EpiMoe1 {
    static constexpr bool PERM = true, F8 = true;
    unsigned char* ws0; const LAS int* cntl;
    __device__ __forceinline__ void operator()(f32x4 (&acc)[2][2][4][2], const Unit& u, int wr, int wc, int fr, int fq) const {
        unsigned char* ws = ws0; ws = GP(ws);
        const int cg = cntl[u.g]; const int rl0 = wr * 64 + fr;
        float rs8[2][4];
        ROWS8 { const int rg = u.mt * 256 + rl0 + (int)RO(ai, m); rs8[ai][m] = ldo<float>(ws + WS_RSL, (unsigned)(u.g * M + (rg < cg ? rg : 0)) * 4u); }
        ROWS8 { PIN1(rs8[ai][m]); }
        EPI_FENCE(); EPI_LOADS_DONE();
        const unsigned ob = (unsigned)(u.pm * 256 + rl0) * FF + (unsigned)(128 * u.pn + 32 * wc + 8 * fq);
#pragma unroll
        for (int ai = 0; ai < 2; ++ai)
#pragma unroll
            for (int mp = 0; mp < 2; ++mp) { u32x2 f8[2];
#pragma unroll
                for (int k = 0; k < 2; ++k) { const int m = 2 * mp + k; const float rs = rs8[ai][m], rh = __builtin_amdgcn_ldexpf(rs, 2)  ; f32x4 h0, h1;
#pragma unroll
                    for (int i = 0; i < 4; ++i) { h0[i] = clamp_f8(silu(acc[ai][0][m][0][i] * rs) * (acc[ai][1][m][0][i] * rh)); h1[i] = clamp_f8(silu(acc[ai][0][m][1][i] * rs) * (acc[ai][1][m][1][i] * rh)); }
                    f8[k] = pk_fp8x8(h0, h1); }
                asm volatile("s_nop 3\n\tv_permlane16_swap_b32 %0, %2\n\ts_nop 1\n\tv_permlane16_swap_b32 %1, %3\n\ts_nop 3" : "+v"(f8[0].x), "+v"(f8[0].y), "+v"(f8[1].x), "+v"(f8[1].y));
                const unsigned o = (fq & 1) ? (ob + RO(ai, 2 * mp + 1) * FF - 8u) : (ob + RO(ai, 2 * mp) * FF);
                sto<u32x4>(ws + WS_HID, o, (u32x4){f8[0].x, f8[0].y, f8[1].x, f8[1].y}); }
    }
};
struct EpiMoe2 {
    static constexpr bool PERM = true, F8 = true;
    unsigned char* ws0; const LAS int* cntl; bool FINAL;
    __device__ __forceinline__ void operator()(f32x4 (&acc)[2][2][4][2], const Unit& u, int wr, int wc, int fr, int fq) const {
        unsigned char* ws = ws0; ws = GP(ws);
        const int cg = cntl[u.g]; const int rl0 = wr * 64 + fr; const unsigned col0 = (unsigned)(u.pn * 256 + wc * 64 + 8 * fq);
        int tok[2][4];
#pragma unroll
        for (int ai = 0; ai < 2; ++ai) { float w[4]; u32x4 r[4][2];
#pragma unroll
            for (int m = 0; m < 4; ++m) { const int rg = u.mt * 256 + rl0 + (int)RO(ai, m); const unsigned li = (unsigned)(u.g * M + (rg < cg ? rg : 0)) * 4u; tok[ai][m] = ldo<int>(ws + WS_TOKL, li); w[m] = ldo<float>(ws + WS_WL, li) * (1.f / (HID_SCALE * WD_SCALE)); }
#pragma unroll
            for (int m = 0; m < 4; ++m)
#pragma unroll
                for (int bj = 0; bj < 2; ++bj) r[m][bj] = ldo<u32x4>(ws + WS_HB2, ((unsigned)tok[ai][m] * D + col0) * 2u + 64u * bj);
#pragma unroll
            for (int m = 0; m < 4; ++m)
#pragma unroll
                for (int bj = 0; bj < 2; ++bj) { f32x4 ra, rb; up_bf16x8(r[m][bj], ra, rb); acc[ai][bj][m][0] = ra + acc[ai][bj][m][0] * w[m]; acc[ai][bj][m][1] = rb + acc[ai][bj][m][1] * w[m]; PIN4(acc[ai][bj][m][0]); PIN4(acc[ai][bj][m][1]); } }
        EPI_FENCE(); EPI_LOADS_DONE();
        ROWS8 { const int rg = u.mt * 256 + rl0 + (int)RO(ai, m); const bool valid = rg < cg; float s2 = 0.f;
            if (valid) {
#pragma unroll
                for (int bj = 0; bj < 2; ++bj) { const f32x4 va = acc[ai][bj][m][0], vb = acc[ai][bj][m][1]; sto_bf16x8(ws + WS_HB2, ((unsigned)tok[ai][m] * D + col0) * 2u + 64u * bj, va, vb); if (FINAL) s2 += sq8(va, vb); }
            }
            if (FINAL) { s2 += shx(s2, 16); s2 += shx(s2, 32); if (fq == 0 && valid) sto<float>(ws + SS_PG, ((unsigned)tok[ai][m] * 16u + (unsigned)(u.pn * 4 + wc)) * 4u, s2); } }
    }
};
struct EpiPle1 {
    static constexpr bool PERM = true, F8 = false;
    unsigned char* ws0;
    __device__ __forceinline__ void operator()(f32x4 (&acc)[2][2][4][2], const Unit& u, int wr, int wc, int fr, int fq) const {
        unsigned char* ws = ws0; ws = GP(ws);
        const int rowb = u.pm * 256 + wr * 64 + fr, col0 = u.pn * 256 + wc * 64 + 8 * fq;
        const unsigned ob = ((unsigned)rowb * D + (unsigned)col0) * 2u;
        EPI_LOADS_DONE();
        float ss8[2][4];
        ROWS8 { float s2 = 0.f;
#pragma unroll
            for (int bj = 0; bj < 2; ++bj) { const f32x4 a = acc[ai][bj][m][0], b = acc[ai][bj][m][1];
                sto_bf16x8(ws + WS_PLERAW, ob + RO(ai, m) * (D * 2u) + 64u * bj, a, b);
                const f32x4 qa = a * a, qb = b * b; s2 += (qa[0] + qa[1]) + (qa[2] + qa[3]) + (qb[0] + qb[1]) + (qb[2] + qb[3]); }
            s2 += shx(s2, 16); s2 += shx(s2, 32); ss8[ai][m] = s2; }
        SS_STORE8(ws + SS_PLE, rowb, u.pn * 4 + wc, ss8);
    }
};
struct EpiPle2 {
    static constexpr bool PERM = true, F8 = false;
    float* outf; unsigned char* ws0; int l;
    __device__ __forceinline__ void operator()(f32x4 (&acc)[2][2][4][2], const Unit& u, int wr, int wc, int fr, int fq) const {
        unsigned char* ws = ws0; ws = GP(ws);
        const float* pgain = inp(18) + l * D;
        const int rowb = u.pm * 256 + wr * 64 + fr, col0 = u.pn * 256 + wc * 64 + 8 * fq;
        const unsigned ob = ((unsigned)rowb * D + (unsigned)col0) * 2u;
        float r8[2][4]; rs_rows8((const float*)(ws + SS_PG), rowb, fq, r8);
        ROWS8 {
#pragma unroll
            for (int bj = 0; bj < 2; ++bj)
#pragma unroll
                for (int n = 0; n < 2; ++n) {
#pragma unroll
                    for (int i = 0; i < 4; ++i) acc[ai][bj][m][n][i] = __builtin_amdgcn_rcpf(1.f + fast_exp(-(acc[ai][bj][m][n][i] * r8[ai][m])));
                    PIN4(acc[ai][bj][m][n]); } }
        EPI_FENCE();
        rs_rows8((const float*)(ws + SS_PLE), rowb, fq, r8);
        f32x4 gn[2][2];
#pragma unroll
        for (int bj = 0; bj < 2; ++bj)
#pragma unroll
            for (int n = 0; n < 2; ++n) gn[bj][n] = ldo<f32x4>(pgain, (unsigned)(col0 + bj * 32 + 4 * n) * 4u);
        EPI_FENCE();
#pragma unroll
        for (int ai = 0; ai < 2; ++ai)
#pragma unroll
            for (int mh = 0; mh < 2; ++mh) { u32x4 rh[2][2], rr[2][2];
#pragma unroll
                for (int m2 = 0; m2 < 2; ++m2)
#pragma unroll
                    for (int bj = 0; bj < 2; ++bj) { const unsigned o = ob + RO(ai, 2 * mh + m2) * (D * 2u) + 64u * bj; rh[m2][bj] = ldo<u32x4>(ws + WS_HB2, o); rr[m2][bj] = ldo<u32x4>(ws + WS_PLERAW, o); }
#pragma unroll
                for (int m2 = 0; m2 < 2; ++m2) { const int m = 2 * mh + m2; const float rp = r8[ai][m];
#pragma unroll
                    for (int bj = 0; bj < 2; ++bj) { f32x4 ha, hb2, pa, pb; up_bf16x8(rh[m2][bj], ha, hb2); up_bf16x8(rr[m2][bj], pa, pb);
                        acc[ai][bj][m][0] = ha + (pa * rp * gn[bj][0]) * acc[ai][bj][m][0]; acc[ai][bj][m][1] = hb2 + (pb * rp * gn[bj][1]) * acc[ai][bj][m][1]; PIN4(acc[ai][bj][m][0]); PIN4(acc[ai][bj][m][1]); } }
                EPI_FENCE(); }
        EPI_LOADS_DONE();
        float ss8[2][4];
        ROWS8 { float s2 = 0.f;
#pragma unroll
            for (int bj = 0; bj < 2; ++bj) { const unsigned o = ob + RO(ai, m) * (D * 2u) + 64u * bj; const f32x4 ha = acc[ai][bj][m][0], hb2 = acc[ai][bj][m][1];
                if (outf) { sto<f32x4>(outf, o * 2u, ha); sto<f32x4>(outf, o * 2u + 16u, hb2); }
                else { sto_bf16x8(ws + WS_HB, o, ha, hb2); s2 += sq8(ha, hb2); } }
            s2 += shx(s2, 16); s2 += shx(s2, 32); ss8[ai][m] = s2; }
        if (!outf) SS_STORE8(ws + SS_MIX, rowb, u.pn * 4 + wc, ss8);
    }
};

struct Args { const float* in[21]; float* out; unsigned char* ws; int ph_lo, ph_hi; };

struct Ctx {
    LAS unsigned char* lds; int tid, lane, wave, G, c, vcu;
    float* h; unsigned char* ws;
};
__device__ __forceinline__ float wave_sum(float v) {
#pragma unroll
    for (int o = 1; o < 64; o <<= 1) v += shx(v, o);
    return v;
}

struct TrItem { const float* W; const float* gain; bf16* WT; int N, Kt, dst_row0, c0, c1, k0; float f8scale; };
__device__ __forceinline__ void tr_load(const TrItem& t, f32x4 (&v)[16], int lane) {
    const int r = lane >> 4, c = lane & 15; const int scol = (c < 8) ? (t.c0 + 4 * c) : (t.c1 + 4 * (c - 8));
#pragma unroll
    for (int i = 0; i < 16; ++i) v[i] = *(const f32x4*)(t.W + (size_t)(t.k0 + 4 * i + r) * t.N + scol);
}
__device__ __forceinline__ void tr_store(const TrItem& t, const f32x4 (&v)[16], LAS float* scr, int lane) {
    const int r = lane >> 4, c = lane & 15;
#pragma unroll
    for (int i = 0; i < 16; ++i) { LAS float* d = scr + (4 * i + r) * 65 + 4 * c; d[0] = v[i][0]; d[1] = v[i][1]; d[2] = v[i][2]; d[3] = v[i][3]; }
    asm volatile("s_waitcnt lgkmcnt(0)" ::: "memory");
    const int kc = lane & 7;
    f32x4 g0 = (f32x4){1.f, 1.f, 1.f, 1.f}, g1 = g0;
    if (t.gain) { g0 = *(const f32x4*)(t.gain + t.k0 + 8 * kc); g1 = *(const f32x4*)(t.gain + t.k0 + 8 * kc + 4); }
    if (t.f8scale != 0.f) { g0 = g0 * t.f8scale; g1 = g1 * t.f8scale; unsigned char* W8 = (unsigned char*)t.WT;
#pragma unroll
        for (int j = 0; j < 8; ++j) { const int n = (lane >> 3) + 8 * j; const LAS float* sp = scr + (8 * kc) * 65 + n;
            const f32x4 a = (f32x4){sp[0 * 65] * g0[0], sp[1 * 65] * g0[1], sp[2 * 65] * g0[2], sp[3 * 65] * g0[3]}, b = (f32x4){sp[4 * 65] * g1[0], sp[5 * 65] * g1[1], sp[6 * 65] * g1[2], sp[7 * 65] * g1[3]};
            *(u32x2*)(W8 + (size_t)(t.dst_row0 + n) * t.Kt + t.k0 + 8 * kc) = pk_fp8x8(a, b); }
    } else {
#pragma unroll
    for (int j = 0; j < 8; ++j) { const int n = (lane >> 3) + 8 * j; const LAS float* sp = scr + (8 * kc) * 65 + n;
        u32x4 o; o.x = cvt_pk_bf16(sp[0 * 65] * g0[0], sp[1 * 65] * g0[1]); o.y = cvt_pk_bf16(sp[2 * 65] * g0[2], sp[3 * 65] * g0[3]);
        o.z = cvt_pk_bf16(sp[4 * 65] * g1[0], sp[5 * 65] * g1[1]); o.w = cvt_pk_bf16(sp[6 * 65] * g1[2], sp[7 * 65] * g1[3]);
        *(u32x4*)(t.WT + (size_t)(t.dst_row0 + n) * t.Kt + t.k0 + 8 * kc) = o; }
    }
    asm volatile("s_waitcnt lgkmcnt(0)" ::: "memory");
}

__device__ __forceinline__ void prologue(Ctx& X) {
    unsigned char* ws = X.ws;
    const int tid = opaque_tid(X.wave), lane = tid & 63, wave = __builtin_amdgcn_readfirstlane(tid >> 6);
    LAS float* scr = (LAS float*)(X.lds + wave * 16640);
    const int gw = X.vcu * 8 + wave, NGW = X.G * 8;
    const float *w_in = inp(4), *w_out = inp(10), *w_gate = inp(14), *w_up = inp(15), *w_down = inp(16), *w_ple = inp(17), *w_pg = inp(20);
    const float *mix_norm = inp(3), *ffn_norm = inp(11), *pg_norm = inp(19);
    constexpr int I_IN = 16 * 44, I_OUT = 16 * 16, I_GU = 32 * 16 * 16, I_D = 32 * 8 * 16, I_PLE = 4 * 16, I_PG = 16 * 16;
    constexpr int I_LAYER = I_IN + I_OUT + I_GU + I_D + I_PLE + I_PG;
#define NCOL(gp) (256 * ((2 * (gp)) >> 3) + 64 * ((2 * (gp)) & 3) + 32 * (((2 * (gp)) >> 2) & 1))
    auto decode = [&](int it, TrItem& t) {
        const int l = it / I_LAYER; int r = it % I_LAYER;
        if (r < I_IN) { const int kb = r / 44, gp = r % 44, gi = 2 * gp, pn = gi >> 3, bj = (gi >> 2) & 1, wc = gi & 3;
            int sc, sc1;
            if (pn <= 2) { sc = 256 * pn + 64 * wc + 32 * bj; sc1 = sc + 64; }
            else { const int hd = (pn - 3) >> 1, tb = (pn - 3) & 1; sc = (tb ? (bj ? 2304 : 1792) : (bj ? 1280 : 768)) + hd * 128 + 32 * wc; sc1 = sc + 32; }
            t = TrItem{w_in + (size_t)l * D * IN_W, mix_norm + l * D, (bf16*)(ws + WS_WIN) + (size_t)l * IN_W * D, IN_W, D, 64 * gp, sc, sc1, 64 * kb, 0.f}; return; }
        r -= I_IN;
        if (r < I_OUT) { const int kb = r / 16, gp = r % 16;
            t = TrItem{w_out + (size_t)l * D * D, nullptr, (bf16*)(ws + WS_WOUT + (size_t)l * D * D), D, D, 64 * gp, NCOL(gp), NCOL(gp) + 64, 64 * kb, WOUT_SCALE}; return; }
        r -= I_OUT;
        if (r < I_GU) { const int e = r / 256, q = r % 256, kb = q / 16, gp = q % 16, gi = 2 * gp, pn = gi >> 3, bj = (gi >> 2) & 1, xg = gi & 3; const int sc = 128 * pn + 32 * xg;
            t = TrItem{(bj ? w_up : w_gate) + (size_t)(l * NEXP + e) * D * FF, ffn_norm + l * D, (bf16*)(ws + WS_WGU + (size_t)(l * NEXP + e) * 1024 * D), FF, D, 64 * gp, sc, sc + 32, 64 * kb, 32.f}; return; }
        r -= I_GU;
        if (r < I_D) { const int e = r / 128, q = r % 128, kb = q / 16, gp = q % 16;
            t = TrItem{w_down + (size_t)(l * NEXP + e) * FF * D, nullptr, (bf16*)(ws + WS_WD + (size_t)(l * NEXP + e) * D * FF), D, FF, 64 * gp, NCOL(gp), NCOL(gp) + 64, 64 * kb, WD_SCALE}; return; }
        r -= I_D;
        if (r < I_PLE) { const int kb = r / 16, gp = r % 16;
            t = TrItem{w_ple + (size_t)l * PLE * D, nullptr, (bf16*)(ws + WS_WPLE) + (size_t)l * D * PLE, D, PLE, 64 * gp, NCOL(gp), NCOL(gp) + 64, 64 * kb, 0.f}; return; }
        r -= I_PLE;
        { const int kb = r / 16, gp = r % 16;
            t = TrItem{w_pg + (size_t)l * D * D, pg_norm + l * D, (bf16*)(ws + WS_WPG) + (size_t)l * D * D, D, D, 64 * gp, NCOL(gp), NCOL(gp) + 64, 64 * kb, 0.f}; }
    };
    {
        f32x4 cur[16], nxt[16]; TrItem tc, tn; int it = gw;
        if (it < DEPTH * I_LAYER) { decode(it, tc); tr_load(tc, cur, lane); }
        while (it < DEPTH * I_LAYER) {
            const int itn = it + NGW; const bool more = itn < DEPTH * I_LAYER;
            if (more) { decode(itn, tn); tr_load(tn, nxt, lane); }
            tr_store(tc, cur, scr, lane);
            if (more) { tc = tn;
#pragma unroll
                for (int i = 0; i < 16; ++i) cur[i] = nxt[i]; }
            it = itn;
        }
    }
    const int gt = X.vcu * 512 + tid, NGT = X.G * 512;
    { const float *w_rg = inp(12), *w_re = inp(13); bf16* WR = (bf16*)(ws + WS_WR);
      for (int i = gt; i < DEPTH * 64 * D; i += NGT) { const int l = i / (64 * D), j = (i / D) % 64, k = i % D; float v = 0.f;
          if (j < 4) v = w_rg[((size_t)l * D + k) * 4 + j]; else if (j < 36) v = w_re[((size_t)l * D + k) * 32 + (j - 4)];
          WR[i] = (bf16)f2bf(v * ffn_norm[l * D + k]); } }
    { const f32x4* p4 = (const f32x4*)inp(1); u32x2* o = (u32x2*)(ws + WS_PB);
      for (size_t i = gt; i < (size_t)DEPTH * M * PLE / 4; i += NGT) { const f32x4 v = p4[i]; u32x2 w; w.x = pk2(v[0], v[1]); w.y = pk2(v[2], v[3]); o[i] = w; } }
    { const int* pos = (const int*)inp(2); float* cosT = (float*)(ws + WS_MISC + MISC_COS);
      for (int i = gt; i < M * 8; i += NGT) { const int j = i & 7; const int t = i >> 3;
          const double f = (j == 0) ? 1.0 : (j == 1) ? 0.19392274474868576 : (j == 2) ? 0.03760603093086393 : (j == 3) ? 0.007292664737217109 : (j == 4) ? 0.001414213562373095 : (j == 5) ? 0.0002742481756762073 : (j == 6) ? 5.318295896944988e-05 : 1.031338537721246e-05;
          const double x = (double)pos[t] * f; const double q = __builtin_rint(x * 0.6366197723675814); const double rr = (x - q * 1.5707963267948966) - q * 6.123233995736766e-17;
          const double r2 = rr * rr;
          double sn = rr * (1.0 + r2 * (-1.0 / 6 + r2 * (1.0 / 120 + r2 * (-1.0 / 5040 + r2 * (1.0 / 362880 + r2 * (-1.0 / 39916800 + r2 * (1.0 / 6227020800.0)))))));
          double cs = 1.0 + r2 * (-0.5 + r2 * (1.0 / 24 + r2 * (-1.0 / 720 + r2 * (1.0 / 40320 + r2 * (-1.0 / 3628800 + r2 * (1.0 / 479001600.0 + r2 * (-1.0 / 87178291200.0)))))));
          const int qi = (int)((long long)q & 3);
          const double s_ = (qi == 0) ? sn : (qi == 1) ? cs : (qi == 2) ? -sn : -cs;
          const double c_ = (qi == 0) ? cs : (qi == 1) ? -sn : (qi == 2) ? -cs : sn;
          h16x2 pr; pr[0] = (_Float16)(float)c_; pr[1] = (_Float16)(float)s_; ((unsigned*)cosT)[i] = __builtin_bit_cast(unsigned, pr); } }
    { const float* lbl = inp(8); float* LB = (float*)(ws + WS_MISC + MISC_LB);
      for (int i = gt; i < 512; i += NGT) { const float a0 = lbl[i], a1 = lbl[512 + i], a2 = lbl[1024 + i], a3 = lbl[1536 + i]; const float mx = fmaxf(fmaxf(a0, a1), fmaxf(a2, a3));
          const float e0 = __expf(a0 - mx), e1 = __expf(a1 - mx), e2 = __expf(a2 - mx), e3 = __expf(a3 - mx); const float inv = 1.f / (e0 + e1 + e2 + e3);
          LB[i] = 0.f; LB[512 + i] = e1 * inv; LB[1024 + i] = (e1 + e2) * inv; LB[1536 + i] = (e1 + e2 + e3) * inv; } }
    { const float* x = inp(0); bf16* HB = (bf16*)(ws + WS_HB); float* ss = (float*)(ws + SS_MIX);
      for (int m = gw; m < M; m += NGW) { const f32x4* xr = (const f32x4*)(x + (size_t)m * D) + lane; u32x2* br = (u32x2*)(HB + (size_t)m * D) + lane; float s = 0.f;
#pragma unroll
          for (int j = 0; j < 4; ++j) { const f32x4 v = xr[64 * j]; u32x2 w; w.x = pk2(v[0], v[1]); w.y = pk2(v[2], v[3]); br[64 * j] = w; s += (v[0] * v[0] + v[1] * v[1]) + (v[2] * v[2] + v[3] * v[3]); }
          s = wave_sum(s); if (lane < 16) ss[(size_t)m * 16 + lane] = (lane == 0) ? s : 0.f; } }
}

__device__ __forceinline__ int crow(int reg, int h) { return (reg & 3) + 8 * (reg >> 2) + 4 * h; }
__device__ __forceinline__ void tr_read2(unsigned a0, unsigned a1, s16x4& r0, s16x4& r1) {
    asm volatile("ds_read_b64_tr_b16 %0, %2\n\tds_read_b64_tr_b16 %1, %3\n\ts_waitcnt lgkmcnt(0)" : "=&v"(r0), "=&v"(r1) : "v"(a0), "v"(a1) : "memory");
}
__device__ __forceinline__ void attn_phase(Ctx& X, int layer) {
    const bf16* Q = (const bf16*)(X.ws + WS_Q); const bf16* Kb = (const bf16*)(X.ws + WS_K); const bf16* Vb = (const bf16*)(X.ws + WS_V); bf16* MIX = (bf16*)(X.ws + WS_MIX);
    const float* sinks = inp(7) + layer * 8;
    LAS bf16* Ks = (LAS bf16*)X.lds; LAS bf16* Vs = (LAS bf16*)(X.lds + 36864);
    const unsigned vs_base = (unsigned)(size_t)Vs;
    const int tid = opaque_tid(X.wave), lane = tid & 63, wid = __builtin_amdgcn_readfirstlane(tid >> 6), r = lane & 31, hh = lane >> 5;
    const int tq = (lane & 15) >> 2, tp = lane & 3, dsub = (lane >> 4) & 1;
#pragma unroll 1
    for (int unit = X.c; unit < 512; unit += X.G) {
        const int b = unit >> 7, rem = unit & 127, nblk = rem >> 1, kvh = rem & 1;
        const int m0 = b * SEQ + nblk * 128;
        bf16x8 qfn[4];
#define ATT_QLOAD(tt_) do { const int task_ = wid + 8 * (tt_), hq_ = kvh * 4 + (task_ & 3), qs_ = task_ >> 2; _Pragma("unroll") for (int ks = 0; ks < 4; ++ks) qfn[ks] = *(const bf16x8*)(Q + (size_t)(m0 + 32 * qs_ + r) * 512 + hq_ * 64 + 16 * ks + 8 * hh); } while (0)
        ATT_QLOAD(0);
        __syncthreads();
#pragma unroll
        for (int j = 0; j < 4; ++j) { const int idx = tid + 512 * j, key = idx >> 3, ch = idx & 7; const bool valid = (nblk > 0) || (key >= 128);
            u32x4 kv = (u32x4){0u, 0u, 0u, 0u}, vv = (u32x4){0u, 0u, 0u, 0u};
            if (valid) { const size_t o = (size_t)(m0 - 128 + key) * 128 + kvh * 64 + ch * 8; kv = *(const u32x4*)(Kb + o); vv = *(const u32x4*)(Vb + o); }
            *(LAS u32x4*)(Ks + key * 72 + ch * 8) = kv; *(LAS u32x4*)(Vs + key * 72 + ch * 8) = vv; }
        __syncthreads();
#pragma unroll 1
        for (int tt = 0; tt < 2; ++tt) {
            const int task = wid + 8 * tt, hl = task & 3, qs = task >> 2, hq = kvh * 4 + hl;
            const float sink = sinks[hq];
            bf16x8 qf[4];
#pragma unroll
            for (int ks = 0; ks < 4; ++ks) qf[ks] = qfn[ks];
            f32x16 s[5];
#pragma unroll
            for (int kt = 0; kt < 5; ++kt) {
#pragma unroll
                for (int i = 0; i < 16; ++i) s[kt][i] = 0.f;
#pragma unroll
                for (int ks = 0; ks < 4; ++ks) { const bf16x8 kf = *(const LAS bf16x8*)(Ks + (32 * (qs + kt) + r) * 72 + 16 * ks + 8 * hh); s[kt] = MFMA32(kf, qf[ks], s[kt]); }
            }
            if (tt == 0) ATT_QLOAD(1);
            const int qi = 32 * qs + r; float mx = sink;
#pragma unroll
            for (int kt = 0; kt < 5; ++kt)
#pragma unroll
                for (int i = 0; i < 16; ++i) { const int kj = 32 * (qs + kt) + crow(i, hh); const bool ok = (kj > qi) && (kj <= qi + 128) && ((nblk > 0) || (kj >= 128));
                    const float v = ok ? s[kt][i] : -1e30f; s[kt][i] = v; mx = fmaxf(mx, v); }
            mx = fmaxf(mx, shx(mx, 32));
            float sum = 0.f;
#pragma unroll
            for (int kt = 0; kt < 5; ++kt)
#pragma unroll
                for (int i = 0; i < 16; ++i) { const float e = fast_exp(s[kt][i] - mx); s[kt][i] = e; sum += e; }
            sum += shx(sum, 32);
            const float inv = __builtin_amdgcn_rcpf(sum + fast_exp(sink - mx));
            f32x16 o[2];
#pragma unroll
            for (int i = 0; i < 16; ++i) { o[0][i] = 0.f; o[1][i] = 0.f; }
#pragma unroll
            for (int kt = 0; kt < 5; ++kt)
#pragma unroll
                for (int st = 0; st < 2; ++st) {
                    u32x4 pw; pw.x = cvt_pk_bf16(s[kt][8 * st + 0], s[kt][8 * st + 1]); pw.y = cvt_pk_bf16(s[kt][8 * st + 2], s[kt][8 * st + 3]);
                    pw.z = cvt_pk_bf16(s[kt][8 * st + 4], s[kt][8 * st + 5]); pw.w = cvt_pk_bf16(s[kt][8 * st + 6], s[kt][8 * st + 7]);
                    const bf16x8 pb = __builtin_bit_cast(bf16x8, pw);
                    const int key0 = 32 * (qs + kt) + 16 * st + 4 * hh;
#pragma unroll
                    for (int nt = 0; nt < 2; ++nt) { s16x4 lo, hi; const unsigned va = vs_base + (unsigned)((key0 + tq) * 72 + 32 * nt + 16 * dsub + 4 * tp) * 2u;
                        tr_read2(va, va + 8 * 72 * 2, lo, hi);
                        const bf16x8 vt = __builtin_shufflevector(lo, hi, 0, 1, 2, 3, 4, 5, 6, 7);
                        o[nt] = MFMA32(vt, pb, o[nt]); }
                }
            unsigned char* orow = (unsigned char*)MIX + (size_t)(m0 + 32 * qs + r) * D + hq * 64 + 8 * hh;
            const float invs = __builtin_amdgcn_ldexpf(inv, 2)  ;
#pragma unroll
            for (int nt = 0; nt < 2; ++nt)
#pragma unroll
                for (int gp = 0; gp < 2; ++gp) { const int g0 = 2 * gp, g1 = 2 * gp + 1;
                    int wa = __builtin_amdgcn_cvt_pk_fp8_f32(clamp_f8(o[nt][4 * g0] * invs), clamp_f8(o[nt][4 * g0 + 1] * invs), 0, false); wa = __builtin_amdgcn_cvt_pk_fp8_f32(clamp_f8(o[nt][4 * g0 + 2] * invs), clamp_f8(o[nt][4 * g0 + 3] * invs), wa, true);
                    int wb = __builtin_amdgcn_cvt_pk_fp8_f32(clamp_f8(o[nt][4 * g1] * invs), clamp_f8(o[nt][4 * g1 + 1] * invs), 0, false); wb = __builtin_amdgcn_cvt_pk_fp8_f32(clamp_f8(o[nt][4 * g1 + 2] * invs), clamp_f8(o[nt][4 * g1 + 3] * invs), wb, true);
                    asm volatile("s_nop 3\n\tv_permlane32_swap_b32 %0, %1\n\ts_nop 3" : "+v"(wa), "+v"(wb));
                    *(u32x2*)(orow + 32 * nt + 16 * gp) = (u32x2){(unsigned)wa, (unsigned)wb}; }
        }
    }
}

constexpr int HG_P = 136;
constexpr int HG_QH = 0, HG_KH = 17408, HG_V = 34816, HG_AL = 52224, HG_OL = 61440, HG_SC = 95232;
__device__ __forceinline__ void tr_read4(unsigned a0, unsigned a1, unsigned a2, unsigned a3, s16x4& r0, s16x4& r1, s16x4& r2, s16x4& r3) {
    asm volatile("ds_read_b64_tr_b16 %0, %4\n\tds_read_b64_tr_b16 %1, %5\n\tds_read_b64_tr_b16 %2, %6\n\tds_read_b64_tr_b16 %3, %7\n\ts_waitcnt lgkmcnt(0)"
                 : "=&v"(r0), "=&v"(r1), "=&v"(r2), "=&v"(r3) : "v"(a0), "v"(a1), "v"(a2), "v"(a3) : "memory");
}
template <bool PASS2>
__device__ __forceinline__ void hgrn_pass(Ctx& X, int layer) {
    const bf16* QHg = (const bf16*)(X.ws + WS_QR); const bf16* KHg = (const bf16*)(X.ws + WS_KEY); const bf16* Vg = (const bf16*)(X.ws + WS_IR); const bf16* GR = (const bf16*)(X.ws + WS_GR);
    const float* CHS = (const float*)(X.ws + WS_CHS); float* USUP = (float*)(X.ws + WS_USUP); float* DSUP = (float*)(X.ws + WS_MISC + MISC_DSUP); bf16* MIX = (bf16*)(X.ws + WS_MIX);
    const float* rnorm = inp(9) + layer * 128;
    LAS unsigned char* lds = X.lds;
    LAS bf16* QHs = (LAS bf16*)(lds + HG_QH); LAS bf16* KHs = (LAS bf16*)(lds + HG_KH); LAS bf16* Vs = (LAS bf16*)(lds + HG_V); LAS bf16* AL = (LAS bf16*)(lds + HG_AL);
    LAS float* OL = (LAS float*)(lds + HG_OL); LAS float* SC = (LAS float*)(lds + HG_SC);
    const int tid = opaque_tid(X.wave), lane = tid & 63, wid = __builtin_amdgcn_readfirstlane(tid >> 6), r16 = lane & 15, g4 = lane >> 4;
    const int prow = tid >> 4, pc16 = tid & 15;
    const unsigned vs_base = (unsigned)(size_t)Vs, kh_base = (unsigned)(size_t)KHs;
    const int tq = (lane & 15) >> 2, tp = lane & 3;
#pragma unroll 1
    for (int unit = X.c; unit < 512; unit += X.G) {
        const int bh = unit >> 5, sc = unit & 31, b = bh >> 2, hd = bh & 3;
        const int m0 = b * SEQ + sc * 256, cb = hd * 128;
        f32x4 S[8];
#pragma unroll
        for (int mt = 0; mt < 8; ++mt) S[mt] = (f32x4){0.f, 0.f, 0.f, 0.f};
        if (PASS2 && sc > 0) {
#pragma unroll
            for (int mt = 0; mt < 8; ++mt) S[mt] = *(const f32x4*)(USUP + ((size_t)unit * 128 + 16 * wid + r16) * 128 + 16 * mt + 4 * g4);
        }
        float dprod = 1.f;
        u32x4 pq[2], pk[2], pv[2]; float psc[3] = {0.f, 0.f, 0.f};
        {
            const size_t g0 = (size_t)(m0 + prow) * 512 + cb + 8 * pc16, g1 = g0 + (size_t)32 * 512;
            pk[0] = *(const u32x4*)(KHg + g0); pk[1] = *(const u32x4*)(KHg + g1); pv[0] = *(const u32x4*)(Vg + g0); pv[1] = *(const u32x4*)(Vg + g1);
            if (PASS2) { pq[0] = *(const u32x4*)(QHg + g0); pq[1] = *(const u32x4*)(QHg + g1); }
            if (tid < 128) { const size_t co = (size_t)(m0 >> 6) * 512 + cb + tid;
#pragma unroll
                for (int k = 0; k < 3; ++k) psc[k] = CHS[(size_t)k * (M / 64) * 512 + co]; }
        }
        __syncthreads();
#pragma unroll 1
        for (int ch = 0; ch < 4; ++ch) {
            const int row0 = m0 + 64 * ch;
            *(LAS u32x4*)(KHs + prow * HG_P + 8 * pc16) = pk[0]; *(LAS u32x4*)(KHs + (prow + 32) * HG_P + 8 * pc16) = pk[1];
            *(LAS u32x4*)(Vs + prow * HG_P + 8 * pc16) = pv[0]; *(LAS u32x4*)(Vs + (prow + 32) * HG_P + 8 * pc16) = pv[1];
            if (PASS2) { *(LAS u32x4*)(QHs + prow * HG_P + 8 * pc16) = pq[0]; *(LAS u32x4*)(QHs + (prow + 32) * HG_P + 8 * pc16) = pq[1]; }
            if (tid < 128) { SC[tid] = psc[0]; SC[128 + tid] = psc[1]; SC[256 + tid] = psc[2]; dprod *= psc[2]; }
            __syncthreads();
            if (ch < 3) {
                const size_t g0 = (size_t)(row0 + 64 + prow) * 512 + cb + 8 * pc16, g1 = g0 + (size_t)32 * 512;
                pk[0] = *(const u32x4*)(KHg + g0); pk[1] = *(const u32x4*)(KHg + g1); pv[0] = *(const u32x4*)(Vg + g0); pv[1] = *(const u32x4*)(Vg + g1);
                if (PASS2) { pq[0] = *(const u32x4*)(QHg + g0); pq[1] = *(const u32x4*)(QHg + g1); }
                if (tid < 128) { const size_t co = (size_t)((row0 + 64) >> 6) * 512 + cb + tid;
#pragma unroll
                    for (int k = 0; k < 3; ++k) psc[k] = CHS[(size_t)k * (M / 64) * 512 + co]; }
            }
            bf16x8 vf[2];
            { s16x4 a0, a1, a2, a3; const unsigned va = vs_base + (unsigned)((8 * g4 + tq) * HG_P + 16 * wid + 4 * tp) * 2u;
              tr_read4(va, va + 4 * HG_P * 2, va + 32 * HG_P * 2, va + 36 * HG_P * 2, a0, a1, a2, a3);
              vf[0] = __builtin_shufflevector(a0, a1, 0, 1, 2, 3, 4, 5, 6, 7); vf[1] = __builtin_shufflevector(a2, a3, 0, 1, 2, 3, 4, 5, 6, 7); }
            if (PASS2) {
#pragma unroll
                for (int q2 = 0; q2 < 2; ++q2) { const int tile = 2 * wid + q2, ti = tile >> 2, si = tile & 3; f32x4 a4 = (f32x4){0.f, 0.f, 0.f, 0.f};
                    if (si <= ti) {
#pragma unroll
                        for (int ks = 0; ks < 4; ++ks) { const bf16x8 af = *(const LAS bf16x8*)(QHs + (16 * ti + r16) * HG_P + 32 * ks + 8 * g4), bfr = *(const LAS bf16x8*)(KHs + (16 * si + r16) * HG_P + 32 * ks + 8 * g4); a4 = MFMA16(af, bfr, a4); }
                    }
#pragma unroll
                    for (int rg = 0; rg < 4; ++rg) { const int t = 16 * ti + 4 * g4 + rg, s_ = 16 * si + r16; AL[t * 72 + s_] = (bf16)f2bf((s_ <= t) ? a4[rg] : 0.f); } }
                __syncthreads();
                f32x4 o[4];
#pragma unroll
                for (int mt = 0; mt < 4; ++mt) { o[mt] = (f32x4){0.f, 0.f, 0.f, 0.f};
#pragma unroll
                    for (int ks = 0; ks < 2; ++ks) { const bf16x8 af = *(const LAS bf16x8*)(AL + (16 * mt + r16) * 72 + 32 * ks + 8 * g4); o[mt] = MFMA16(af, vf[ks], o[mt]); } }
#pragma unroll
                for (int k2 = 0; k2 < 4; ++k2) { const f32x4 e0 = *(const LAS f32x4*)(SC + 32 * k2 + 4 * g4), e1 = *(const LAS f32x4*)(SC + 32 * k2 + 16 + 4 * g4);
                    const f32x4 s0 = S[2 * k2] * e0, s1 = S[2 * k2 + 1] * e1;
                    u32x4 sw; sw.x = cvt_pk_bf16(s0[0], s0[1]); sw.y = cvt_pk_bf16(s0[2], s0[3]); sw.z = cvt_pk_bf16(s1[0], s1[1]); sw.w = cvt_pk_bf16(s1[2], s1[3]);
                    const bf16x8 sb = __builtin_bit_cast(bf16x8, sw);
#pragma unroll
                    for (int mt = 0; mt < 4; ++mt) { const LAS bf16* qp = QHs + (16 * mt + r16) * HG_P + 32 * k2 + 4 * g4; const s16x4 lo = *(const LAS s16x4*)qp, hi = *(const LAS s16x4*)(qp + 16);
                        const bf16x8 af = __builtin_shufflevector(lo, hi, 0, 1, 2, 3, 4, 5, 6, 7); o[mt] = MFMA16(af, sb, o[mt]); } }
#pragma unroll
                for (int mt = 0; mt < 4; ++mt)
#pragma unroll
                    for (int rg = 0; rg < 4; ++rg) OL[(16 * mt + 4 * g4 + rg) * 132 + 16 * wid + r16] = o[mt][rg];
            }
#pragma unroll
            for (int mt = 0; mt < 8; ++mt) { s16x4 a0, a1, a2, a3; const unsigned ka = kh_base + (unsigned)((8 * g4 + tq) * HG_P + 16 * mt + 4 * tp) * 2u;
                tr_read4(ka, ka + 4 * HG_P * 2, ka + 32 * HG_P * 2, ka + 36 * HG_P * 2, a0, a1, a2, a3);
                const bf16x8 k0 = __builtin_shufflevector(a0, a1, 0, 1, 2, 3, 4, 5, 6, 7), k1 = __builtin_shufflevector(a2, a3, 0, 1, 2, 3, 4, 5, 6, 7);
                f32x4 T = (f32x4){0.f, 0.f, 0.f, 0.f}; T = MFMA16(k0, vf[0], T); T = MFMA16(k1, vf[1], T);
                const f32x4 ccv = *(const LAS f32x4*)(SC + 128 + 16 * mt + 4 * g4), dcv = *(const LAS f32x4*)(SC + 256 + 16 * mt + 4 * g4);
                S[mt] = S[mt] * dcv + T * ccv; }
            __syncthreads();
            if (PASS2) {
                const int t = tid >> 3, e0 = (tid & 7) * 16; f32x4 v[4]; float s2 = 0.f;
#pragma unroll
                for (int j = 0; j < 4; ++j) { v[j] = *(const LAS f32x4*)(OL + t * 132 + e0 + 4 * j); const f32x4 q = v[j] * v[j]; s2 += (q[0] + q[1]) + (q[2] + q[3]); }
                s2 += shx(s2, 1); s2 += shx(s2, 2); s2 += shx(s2, 4);
                const float rs = rsqrtf(s2 + EPS * 128.f) * 11.313708499f;
                const size_t go = (size_t)(row0 + t) * 512 + cb + e0;
                f32x4 ga, gb, gc, gd; ld_bf16x8(GR + go, ga, gb); ld_bf16x8(GR + go + 8, gc, gd);
                const f32x4 r0 = *(const f32x4*)(rnorm + e0), r1 = *(const f32x4*)(rnorm + e0 + 4), r2 = *(const f32x4*)(rnorm + e0 + 8), r3 = *(const f32x4*)(rnorm + e0 + 12);
                unsigned char* dst = (unsigned char*)MIX + (size_t)(row0 + t) * D + 512 + cb + e0;
                const float rss = __builtin_amdgcn_ldexpf(rs, 2)  ; f32x4 y[4] = {v[0] * rss * r0 * ga, v[1] * rss * r1 * gb, v[2] * rss * r2 * gc, v[3] * rss * r3 * gd};
#pragma unroll
                for (int j = 0; j < 4; ++j)
#pragma unroll
                    for (int i = 0; i < 4; ++i) y[j][i] = clamp_f8(y[j][i]);
                const u32x2 w0 = pk_fp8x8(y[0], y[1]), w1 = pk_fp8x8(y[2], y[3]);
                *(u32x4*)dst = (u32x4){w0.x, w0.y, w1.x, w1.y};
            }
        }
        if (!PASS2) {
#pragma unroll
            for (int mt = 0; mt < 8; ++mt) *(f32x4*)(USUP + ((size_t)unit * 128 + 16 * wid + r16) * 128 + 16 * mt + 4 * g4) = S[mt];
            if (tid < 128) DSUP[unit * 128 + tid] = dprod;
        }
    }
}
__device__ __forceinline__ void hgrn_scan(Ctx& X) {
    float* USUP = (float*)(X.ws + WS_USUP); const float* DSUP = (const float*)(X.ws + WS_MISC + MISC_DSUP);
    const int tid = opaque_tid(X.wave);
    for (int item = X.c * 512 + tid; item < 16 * 4096; item += X.G * 512) {
        const int bh = item >> 12, idx = item & 4095, e = idx >> 5, dk4 = (idx & 31) * 4;
        f32x4 s = (f32x4){0.f, 0.f, 0.f, 0.f};
        for (int s0 = 0; s0 < 32; s0 += 8) {
            f32x4 uv[8], dv[8];
#pragma unroll
            for (int j = 0; j < 8; ++j) { const int u = bh * 32 + s0 + j; uv[j] = *(const f32x4*)(USUP + ((size_t)u * 128 + e) * 128 + dk4); dv[j] = *(const f32x4*)(DSUP + u * 128 + dk4); }
#pragma unroll
            for (int j = 0; j < 8; ++j) { const int u = bh * 32 + s0 + j; *(f32x4*)(USUP + ((size_t)u * 128 + e) * 128 + dk4) = s; s = s * dv[j] + uv[j]; }
        }
    }
}

__device__ __forceinline__ void router_phase(Ctx& X, int layer) {
    const bf16* HB = (const bf16*)(X.ws + WS_HB2); const bf16* WR = (const bf16*)(X.ws + WS_WR) + (size_t)layer * 64 * D;
    const float* ssf = (const float*)(X.ws + SS_FFN);
    unsigned* CNT = (unsigned*)(X.ws + WS_CTL) + CW_CNT; int* TOKL = (int*)(X.ws + WS_TOKL); float* WL = (float*)(X.ws + WS_WL); float* RSL = (float*)(X.ws + WS_RSL);
    LAS bf16* WRs = (LAS bf16*)X.lds;
    LAS float* LOG = (LAS float*)(X.lds + 99328);
    LAS unsigned* HIST = (LAS unsigned*)(X.lds + 124672); LAS unsigned* BASE = (LAS unsigned*)(X.lds + 124928);
    const int tid = opaque_tid(X.wave), lane = tid & 63, wid = __builtin_amdgcn_readfirstlane(tid >> 6), r16 = lane & 15, g4 = lane >> 4;
    __syncthreads();
#pragma unroll
    for (int j = 0; j < 12; ++j) { const int p = tid + 512 * j, row = p >> 7, c16 = p & 127; *(LAS u32x4*)(WRs + row * 1032 + 8 * c16) = *(const u32x4*)(WR + (size_t)row * D + 8 * c16); }
    __syncthreads();
    for (int bt = X.c; bt < M / 128; bt += X.G) {
        const int tok0 = bt * 128 + wid * 16;
        f32x4 acc[3];
#pragma unroll
        for (int nt = 0; nt < 3; ++nt) acc[nt] = (f32x4){0.f, 0.f, 0.f, 0.f};
#pragma unroll 1
        for (int kh = 0; kh < 2; ++kh) { bf16x8 a[16];
#pragma unroll
            for (int k = 0; k < 16; ++k) a[k] = *(const bf16x8*)(HB + (size_t)(tok0 + r16) * D + 32 * (16 * kh + k) + 8 * g4);
#pragma unroll
            for (int k = 0; k < 16; ++k)
#pragma unroll
                for (int nt = 0; nt < 3; ++nt) { const bf16x8 bq = *(const LAS bf16x8*)(WRs + (16 * nt + r16) * 1032 + 32 * (16 * kh + k) + 8 * g4); acc[nt] = MFMA16(a[k], bq, acc[nt]); } }
#pragma unroll
        for (int nt = 0; nt < 3; ++nt)
#pragma unroll
            for (int rg = 0; rg < 4; ++rg) LOG[(wid * 16 + 4 * g4 + rg) * 49 + 16 * nt + r16] = acc[nt][rg];
        if (tid < 64) HIST[tid] = 0u;
        __syncthreads();
        int G0 = 0, G1 = 0; unsigned lr0 = 0, lr1 = 0; float w0 = 0.f, w1 = 0.f, rsl = 0.f; const int tok = tok0 + lane;
        if (lane < 16) {
            const LAS float* lg = LOG + (wid * 16 + lane) * 49; const float rs = rsqrtf(ss_row(ssf, tok) + EPS * D) * 32.f; rsl = rs * (1.f / 32.f);
            float gl[4];
#pragma unroll
            for (int j = 0; j < 4; ++j) gl[j] = lg[j] * rs;
            int gi = 0; float gm = gl[0];
#pragma unroll
            for (int j = 1; j < 4; ++j) if (gl[j] > gm) { gm = gl[j]; gi = j; }
            float gs = 0.f;
#pragma unroll
            for (int j = 0; j < 4; ++j) gs += __expf(gl[j] - gm);
            const float pg = 1.f / gs;
            const LAS float* le = lg + 4 + 8 * gi;
            float el[8];
#pragma unroll
            for (int j = 0; j < 8; ++j) el[j] = le[j] * rs;
            int i1 = 0; float v1 = el[0];
#pragma unroll
            for (int j = 1; j < 8; ++j) if (el[j] > v1) { v1 = el[j]; i1 = j; }
            int i2 = -1; float v2 = -3.0e38f;
#pragma unroll
            for (int j = 0; j < 8; ++j) if (j != i1 && el[j] > v2) { v2 = el[j]; i2 = j; }
            const float ex = __expf(v2 - v1); const float s1 = 1.f / (1.f + ex);
            w0 = pg * s1; w1 = pg * (ex * s1);
            G0 = gi * 8 + i1; G1 = 32 + gi * 8 + i2;
            lr0 = __hip_atomic_fetch_add(&HIST[G0], 1u, __ATOMIC_RELAXED, __HIP_MEMORY_SCOPE_WORKGROUP); lr1 = __hip_atomic_fetch_add(&HIST[G1], 1u, __ATOMIC_RELAXED, __HIP_MEMORY_SCOPE_WORKGROUP);
        }
        __syncthreads();
        if (tid < 64) { const unsigned n = HIST[tid]; BASE[tid] = n ? atomicAdd(&CNT[tid], n) : 0u; }
        __syncthreads();
        if (lane < 16) { const unsigned p0 = BASE[G0] + lr0, p1 = BASE[G1] + lr1;
            TOKL[(size_t)G0 * M + p0] = tok; WL[(size_t)G0 * M + p0] = w0; RSL[(size_t)G0 * M + p0] = rsl; TOKL[(size_t)G1 * M + p1] = tok; WL[(size_t)G1 * M + p1] = w1; RSL[(size_t)G1 * M + p1] = rsl; }
        __syncthreads();
    }
}
__device__ __forceinline__ void moe_tables(Ctx& X) {
    const unsigned* CNT = (const unsigned*)(X.ws + WS_CTL) + CW_CNT;
    LAS int* PRE = (LAS int*)(X.lds + LC_PRE); LAS int* CNTL = (LAS int*)(X.lds + LC_CNT);
    const int tid = opaque_tid(X.wave);
    __syncthreads();
    if (tid < 64) CNTL[tid] = (int)__hip_atomic_load(CNT + tid, __ATOMIC_RELAXED, __HIP_MEMORY_SCOPE_AGENT);
    __syncthreads();
    if (tid < 64) { int a = 0;
#pragma unroll 8
        for (int g = 0; g < NGRP; ++g) { const int t = (CNTL[g] + 255) >> 8; a += (g <= tid) ? t : 0; }
        PRE[tid + 1] = a; if (tid == 0) PRE[0] = 0; }
    __syncthreads();
}

__global__ void __launch_bounds__(512, 2) hymba_fwd(Args args) {
    extern __shared__ __attribute__((aligned(16))) unsigned char smem[];
    Ctx X;
    X.lds = (LAS unsigned char*)smem; X.tid = 0; X.lane = 0; X.wave = __builtin_amdgcn_readfirstlane((int)threadIdx.x >> 6);
    X.G = gridDim.x; X.c = blockIdx.x; { const int bx = blockIdx.x; X.vcu = (X.G % 8 == 0) ? (bx % 8) * (X.G / 8) + bx / 8 : bx; }
    X.h = GP(args.out); X.ws = GP(args.ws);
    unsigned char* ws0 = GP(args.ws);
    for (int u = threadIdx.x; u < (LDS_BYTES - LC_BASE) / 4; u += 512) ((LAS unsigned*)(X.lds + LC_BASE))[u] = 0u;
    __syncthreads();
    const int lo = args.ph_lo, hi = args.ph_hi;
    const bool multi = (hi - lo) > 1;
    XcdBarrier bar; bar.bar = (unsigned*)(ws0 + WS_CTL) + CW_BAR; bar.x = 0; bar.st = nullptr;
    if (multi) bar = xcd_barrier_post((unsigned*)(ws0 + WS_CTL) + CW_BAR, (volatile LAS unsigned*)(X.lds + LC_BAR));
#ifndef PH_MASK
#define PH_MASK 0x7ff
#endif
#define PHASE_WS unsigned char* ws = GP(ws0); X.ws = ws; asm volatile("" : "+s"(X.G), "+s"(X.c), "+s"(X.vcu))
#define PHEN(j) (((PH_MASK) >> (j)) & 1)
#define IN(k) (lo <= (k) && (k) < hi)
#define SEAM(k) do { if ((k) + 1 < hi) xcd_barrier(bar, X.wave); } while (0)
    float* ss_mix = (float*)(ws0 + SS_MIX); float* ss_ffn = (float*)(ws0 + SS_FFN);
    float* ss_pg = (float*)(ws0 + SS_PG); float* ss_ple = (float*)(ws0 + SS_PLE);
    bf16* HB = (bf16*)(ws0 + WS_HB);
    const int NGT = X.G * 512;

    if (PHEN(10) && IN(0)) { prologue(X); SEAM(0); }

    for (int l = 0; l < DEPTH; ++l) {
        const int pb = 1 + 10 * l;
        if (PHEN(0) && IN(pb + 0)) { PHASE_WS;
            { int cc = X.c; asm volatile("" : "+s"(cc)); const int gt = cc * 512 + opaque_tid(X.wave);
              if (gt < 64) ((unsigned*)(ws + WS_CTL) + CW_CNT)[gt] = 0u; }
            int cin = X.c; asm volatile("" : "+s"(cin));
            pg8::InSched S; S.soA.init(M, 4 * 256, X.G, cin); S.soB.init(M, IN_W - 4 * 256, X.G, cin); S.split = (X.G == 256); S.A = (const char*)(ws + WS_HB); S.Bt = (const char*)(ws + WS_WIN) + (size_t)l * IN_W * D * 2; S.K = D;
            EpiIn E{ws, l};
            pg8::gemm_phase<EpiIn, pg8::InSched>(X.lds, D, S, E, X.wave);
            SEAM(pb + 0);
        }
        if (PHEN(1) && IN(pb + 1)) { PHASE_WS;
            attn_phase(X, l);
            hgrn_pass<false>(X, l);
            SEAM(pb + 1);
        }
        if (PHEN(2) && IN(pb + 2)) { PHASE_WS; hgrn_scan(X); SEAM(pb + 2); }
        if (PHEN(3) && IN(pb + 3)) { PHASE_WS; hgrn_pass<true>(X, l); SEAM(pb + 3); }
        if (PHEN(4) && IN(pb + 4)) { PHASE_WS;
            pg8::RegSched S; S.so.init(M, D, X.G, X.c); S.A = (const char*)(ws + WS_MIX); S.Bt = (const char*)(ws + WS_WOUT) + (size_t)l * D * D; S.K = D / 2;
            EpiResid E{ws};
            pg8::gemm_phase<EpiResid, pg8::RegSched>(X.lds, D / 2, S, E, X.wave);
            SEAM(pb + 4);
        }
        if (PHEN(5) && IN(pb + 5)) { PHASE_WS;
            router_phase(X, l);
            SEAM(pb + 5);
        }
#pragma unroll 1
        for (int mp = 0; mp < 3; ++mp) {
            if (!(PHEN(6 + mp) && IN(pb + 6 + mp))) continue;
            PHASE_WS;
            if (mp == 0 || !multi) moe_tables(X);
            const LAS int* PRE = (const LAS int*)(X.lds + LC_PRE); const LAS int* CNTL = (const LAS int*)(X.lds + LC_CNT);
            const int U6 = 4 * PRE[64], U7 = 4 * PRE[32], U8 = U6 - U7;
            if (mp == 0) {
                pg8::MoeSched<true> S; S.pre = PRE; S.cntl = CNTL; S.ubeg = 0; S.uend = U6; S.G = X.G; S.c = X.vcu; S.tokl = (const int*)(ws + WS_TOKL); S.A = (const char*)(ws + WS_HB2F8);
                S.W = (const char*)(ws + WS_WGU) + (size_t)l * NEXP * 1024 * D; S.K = D / 2; S.wstride = (size_t)1024 * D;
                EpiMoe1 E{ws, CNTL};
                pg8::gemm_phase<EpiMoe1, pg8::MoeSched<true>>(X.lds, D / 2, S, E, X.wave);
            } else {
                pg8::MoeSched<false> S; S.pre = PRE; S.cntl = CNTL; S.ubeg = (mp == 1) ? 0 : U7; S.uend = (mp == 1) ? U7 : U6; S.G = X.G; S.c = X.vcu; S.tokl = (const int*)(ws + WS_TOKL); S.A = (const char*)(ws + WS_HID);
                S.W = (const char*)(ws + WS_WD) + (size_t)l * NEXP * D * FF; S.K = FF / 2; S.wstride = (size_t)D * FF;
                EpiMoe2 E{ws, CNTL, mp == 2};
                pg8::gemm_phase<EpiMoe2, pg8::MoeSched<false>>(X.lds, FF / 2, S, E, X.wave);
            }
            {
                const int NPL = (M / 256) * (D / 256);
                const int r6 = U6 % X.G, r7 = U7 % X.G, r8 = U8 % X.G;
                const int t6 = (X.G - r6) < NPL ? (X.G - r6) : NPL, t7 = (X.G - r7) < (NPL - t6) ? (X.G - r7) : (NPL - t6), t8 = NPL - t6 - t7;
                pg8::TailSched T; T.G = X.G; T.c = X.vcu;
                T.nunits = (mp == 0) ? t6 : (mp == 1) ? t7 : t8; T.ubase = (mp == 0) ? 0 : (mp == 1) ? t6 : t6 + t7; T.nbig = (mp == 0) ? r6 : (mp == 1) ? r7 : r8;
                T.A = (const char*)(ws + WS_PB) + (size_t)l * M * PLE * 2; T.Bt = (const char*)(ws + WS_WPLE) + (size_t)l * D * PLE * 2; T.K = PLE;
                EpiPle1 E1{ws};
                pg8::gemm_phase<EpiPle1, pg8::TailSched>(X.lds, PLE, T, E1, X.wave);
            }
            SEAM(pb + 6 + mp);
        }
        if (PHEN(9) && IN(pb + 9)) { PHASE_WS;
            pg8::RegSched S; S.so.init(M, D, X.G, X.c); S.A = (const char*)(ws + WS_HB2); S.Bt = (const char*)(ws + WS_WPG) + (size_t)l * D * D * 2; S.K = D;
            EpiPle2 E{(l == DEPTH - 1) ? X.h : nullptr, ws, l};
            pg8::gemm_phase<EpiPle2, pg8::RegSched>(X.lds, D, S, E, X.wave);
            SEAM(pb + 9);
        }
    }
    if (multi && hi == 1 + 10 * DEPTH) {
        if (xb_ld((unsigned*)(ws0 + WS_CTL) + CW_BAR + XB_TMO) != 0u && opaque_tid(X.wave) == 0) X.h[(size_t)blockIdx.x * D] = __builtin_nanf("");
    }
#undef PHASE_WS
#undef IN
#undef SEAM
}

extern "C" void kernel_launch(void* const* d_in, const int* in_sizes, int n_in, void* d_out, int out_size, void* d_ws, size_t ws_size, hipStream_t stream) {
    static int grid = 0;
    if (grid == 0) {
        if (n_in != 21 || out_size != M * D || ws_size < WS_END) { fprintf(stderr, "kernel_launch: unexpected problem (n_in %d, out %d, ws %zu < %zu)\n", n_in, out_size, ws_size, (size_t)WS_END); grid = -1; return; }
        int dev = 0, cus = 0, per_cu = 0;
        if (hipGetDevice(&dev) != hipSuccess || hipDeviceGetAttribute(&cus, hipDeviceAttributeMultiprocessorCount, dev) != hipSuccess) { grid = -1; return; }
        if (hipFuncSetAttribute((const void*)hymba_fwd, hipFuncAttributeMaxDynamicSharedMemorySize, LDS_BYTES) != hipSuccess) { fprintf(stderr, "kernel_launch: hipFuncSetAttribute failed\n"); grid = -1; return; }
        if (hipOccupancyMaxActiveBlocksPerMultiprocessor(&per_cu, (const void*)hymba_fwd, 512, LDS_BYTES) != hipSuccess || per_cu < 1) { fprintf(stderr, "kernel_launch: occupancy query says %d\n", per_cu); per_cu = 1; }
        (void)hipGetLastError();
        grid = cus;
    }
    if (grid < 0) return;
    (void)hipMemsetAsync((char*)d_ws + WS_CTL, 0, CTL_ZERO_BYTES, stream);
    Args a{};
    for (int i = 0; i < 21; ++i) a.in[i] = (const float*)d_in[i];
    a.out = (float*)d_out; a.ws = (unsigned char*)d_ws;
#if ONE_LAUNCH
    a.ph_lo = 0; a.ph_hi = PH_HI;
    hipLaunchKernelGGL(hymba_fwd, dim3(grid), dim3(512), LDS_BYTES, stream, a);
#else
    for (int p = 0; p < PH_HI; ++p) { a.ph_lo = p; a.ph_hi = p + 1; hipLaunchKernelGGL(hymba_fwd, dim3(grid), dim3(512), LDS_BYTES, stream, a); }
#endif
}
```
